# Optimizing an MI355X kernel written in HIP

```python
import math
import jax, jax.numpy as jnp
from jax import lax
import numpy as np

D_MODEL = 1024
BATCH = 8
SEQ = 8192
DEPTH = 2

GRID_W = 64
CTX_LEN = 256
N_MIXERS = 2
N_MOD = 9
D_FF = 2816
D_RNN = D_MODEL
LRU_HEADS = 8
LRU_BLOCK = D_RNN // LRU_HEADS
CONV_W = 4
CONV_LEFT = 2
RG_C = 8.0
CHUNK = 128
D_SGU = 2 * D_MODEL
SGU_GROUPS = 8
SGU_GROUP_W = D_SGU // SGU_GROUPS
EPS = 1e-6
POS_BASE = 10000.0

kernel_name = "hybrid_rglru_chunk_sgu_diffusion_trunk"


def rmsnorm(x, g):
    xf = x.astype(jnp.float32)
    y = xf * lax.rsqrt(jnp.mean(xf * xf, axis=-1, keepdims=True) + EPS)
    return y.astype(x.dtype) * g


def layernorm(x, g, b):
    xf = x.astype(jnp.float32)
    mu = jnp.mean(xf, axis=-1, keepdims=True)
    var = jnp.mean(jnp.square(xf - mu), axis=-1, keepdims=True)
    return ((xf - mu) * lax.rsqrt(var + EPS)).astype(x.dtype) * g + b


def sincos_1d(pos, dim):
    half = dim // 2
    omega = 1.0 / (POS_BASE ** (jnp.arange(half, dtype=jnp.float32) / half))
    ang = pos.astype(jnp.float32)[:, None] * omega[None, :]
    return jnp.concatenate([jnp.sin(ang), jnp.cos(ang)], axis=-1)


def sincos_2d(n_tokens, dim):
    rows = n_tokens // GRID_W
    emb_r = sincos_1d(jnp.arange(rows), dim // 2)
    emb_c = sincos_1d(jnp.arange(GRID_W), dim // 2)
    pe = jnp.concatenate([jnp.broadcast_to(emb_r[:, None, :], (rows, GRID_W, dim // 2)),
                          jnp.broadcast_to(emb_c[None, :, :], (rows, GRID_W, dim // 2))], axis=-1)
    return pe.reshape(rows * GRID_W, dim)


def swiglu(h, w1, w3, w2):
    return (jax.nn.silu(h @ w1) * (h @ w3)) @ w2


def centred_dwconv(x, w, b):
    L = x.shape[1]
    xp = jnp.pad(x, ((0, 0), (CONV_LEFT, CONV_W - 1 - CONV_LEFT), (0, 0)))
    y = xp[:, 0:L] * w[0]
    for k in range(1, CONV_W):
        y = y + xp[:, k:k + L] * w[k]
    return y + b


def _lin_combine(left, right):
    a_l, b_l = left
    a_r, b_r = right
    return a_l * a_r, a_r * b_l + b_r


def rglru_scan(x, wa, ba, wi, bi, lam, h0, reverse):
    B_, L, R = x.shape
    xf = x.astype(jnp.float32)
    xh = xf.reshape(B_, L, LRU_HEADS, LRU_BLOCK)
    r = jax.nn.sigmoid(jnp.einsum('blhi,hij->blhj', xh, wa.astype(jnp.float32)).reshape(B_, L, R) + ba.astype(jnp.float32))
    ig = jax.nn.sigmoid(jnp.einsum('blhi,hij->blhj', xh, wi.astype(jnp.float32)).reshape(B_, L, R) + bi.astype(jnp.float32))
    log_a = -RG_C * r * jax.nn.softplus(-lam.astype(jnp.float32))
    a = jnp.exp(log_a)
    b = jnp.sqrt(-jnp.expm1(2.0 * log_a)) * (ig * xf)
    if reverse:
        a = jnp.flip(a, axis=1)
        b = jnp.flip(b, axis=1)
    b = b.at[:, 0].add(a[:, 0] * h0)
    _, hs = lax.associative_scan(_lin_combine, (a, b), axis=1)
    if reverse:
        hs = jnp.flip(hs, axis=1)
    return hs


def rglru_block(h, w_in, conv_w, conv_b, wa, ba, wi, bi, lam, w_out, h0_f, h0_b):
    z = h @ w_in
    gate_br = jax.nn.gelu(z[..., :D_RNN], approximate=True)
    xc = centred_dwconv(z[..., D_RNN:], conv_w, conv_b)
    hf = rglru_scan(xc, wa[0], ba[0], wi[0], bi[0], lam[0], h0_f, reverse=False)
    hb = rglru_scan(xc, wa[1], ba[1], wi[1], bi[1], lam[1], h0_b, reverse=True)
    y = ((hf + hb).astype(gate_br.dtype) * gate_br) @ w_out
    return y, hf[:, -1], hb[:, 0]


def chunk_sgu(h, w_in, b_in, ln_g, ln_b, ws, bs, w_out):
    B_, L, _ = h.shape
    z = jax.nn.gelu(h @ w_in + b_in, approximate=True)
    u = z[..., :D_SGU]
    v = layernorm(z[..., D_SGU:], ln_g, ln_b)
    v = v.reshape(B_, L // CHUNK, CHUNK, SGU_GROUPS, SGU_GROUP_W)
    s = jnp.einsum('bnpgc,gqp->bnqgc', v, ws) + jnp.transpose(bs)[:, :, None]
    return (u * s.reshape(B_, L, D_SGU)) @ w_out


def setup_inputs(seed: int = 0) -> dict:
    key = jax.random.key(seed)
    ks = iter(jax.random.split(key, 40))
    f32 = jnp.float32

    def nrm(shape, s):
        return jax.random.normal(next(ks), shape, f32) * s

    n_a = len([i for i in range(DEPTH) if i % N_MIXERS == 0])
    n_b = len([i for i in range(DEPTH) if i % N_MIXERS == 1])
    u = jax.random.uniform(next(ks), (n_a, 2, D_RNN), f32, minval=0.9, maxval=0.999)
    a0 = u ** (1.0 / RG_C)
    lam = jnp.log(a0) - jnp.log1p(-a0)
    return {
        "x": nrm((BATCH, SEQ, D_MODEL), 1.0),
        "c": nrm((BATCH, D_MODEL), 1.0),
        "ctx": nrm((BATCH, CTX_LEN, D_MODEL), 1.0),
        "c_ctx": nrm((D_MODEL,), 1.0),
        "ada_w": nrm((DEPTH, D_MODEL, N_MOD * D_MODEL), 0.5 * D_MODEL ** -0.5),
        "ada_b": nrm((DEPTH, N_MOD * D_MODEL), 0.01),
        "norm_pre": 1.0 + nrm((DEPTH, 3, D_MODEL), 0.02),
        "norm_post": 1.0 + nrm((DEPTH, 3, D_MODEL), 0.02),
        "ffn_w1": nrm((DEPTH, 2, D_MODEL, D_FF), D_MODEL ** -0.5),
        "ffn_w3": nrm((DEPTH, 2, D_MODEL, D_FF), D_MODEL ** -0.5),
        "ffn_w2": nrm((DEPTH, 2, D_FF, D_MODEL), D_FF ** -0.5),
        "lru_w_in": nrm((n_a, D_MODEL, 2 * D_RNN), D_MODEL ** -0.5),
        "lru_conv_w": nrm((n_a, CONV_W, D_RNN), CONV_W ** -0.5),
        "lru_conv_b": nrm((n_a, D_RNN), 0.01),
        "lru_wa": nrm((n_a, 2, LRU_HEADS, LRU_BLOCK, LRU_BLOCK), LRU_BLOCK ** -0.5),
        "lru_ba": nrm((n_a, 2, D_RNN), 0.01),
        "lru_wi": nrm((n_a, 2, LRU_HEADS, LRU_BLOCK, LRU_BLOCK), LRU_BLOCK ** -0.5),
        "lru_bi": nrm((n_a, 2, D_RNN), 0.01),
        "lru_lambda": lam,
        "lru_w_out": nrm((n_a, D_RNN, D_MODEL), D_RNN ** -0.5),
        "sgu_w_in": nrm((n_b, D_MODEL, 2 * D_SGU), D_MODEL ** -0.5),
        "sgu_b_in": nrm((n_b, 2 * D_SGU), 0.01),
        "sgu_ln_g": 1.0 + nrm((n_b, D_SGU), 0.02),
        "sgu_ln_b": nrm((n_b, D_SGU), 0.01),
        "sgu_ws": nrm((n_b, SGU_GROUPS, CHUNK, CHUNK), CHUNK ** -0.5),
        "sgu_bs": 1.0 + nrm((n_b, SGU_GROUPS, CHUNK), 0.02),
        "sgu_w_out": nrm((n_b, D_SGU, D_MODEL), D_SGU ** -0.5),
    }


def reference(x, c, ctx, c_ctx, ada_w, ada_b, norm_pre, norm_post, ffn_w1, ffn_w3, ffn_w2,
              lru_w_in, lru_conv_w, lru_conv_b, lru_wa, lru_ba, lru_wi, lru_bi, lru_lambda, lru_w_out,
              sgu_w_in, sgu_b_in, sgu_ln_g, sgu_ln_b, sgu_ws, sgu_bs, sgu_w_out):
    n_lat = x.shape[1]
    x_lat = x + sincos_2d(n_lat, D_MODEL).astype(x.dtype)
    x_ctx = ctx

    def pre(xs, i, k, m):
        return rmsnorm(xs, norm_pre[i, k]) * (1.0 + m[3 * k + 1]) + m[3 * k]

    def post(xs, y, i, k, m, w):
        return xs + w * m[3 * k + 2] * rmsnorm(y, norm_post[i, k])

    def ffn_sub(xs, i, k, j, m):
        y = swiglu(pre(xs, i, k, m), ffn_w1[i, j], ffn_w3[i, j], ffn_w2[i, j])
        return post(xs, y, i, k, m, 0.5)

    for i in range(DEPTH):
        mixer = i % N_MIXERS
        mi = i // N_MIXERS
        need_ctx = any(j % N_MIXERS == 0 for j in range(i, DEPTH))
        ml = (jax.nn.silu(c) @ ada_w[i] + ada_b[i]).reshape(c.shape[0], N_MOD, D_MODEL)
        m_lat = [ml[:, k, None, :] for k in range(N_MOD)]
        mc = (jax.nn.silu(c_ctx) @ ada_w[i] + ada_b[i]).reshape(N_MOD, D_MODEL)
        m_ctx = [mc[k] for k in range(N_MOD)]

        x_lat = ffn_sub(x_lat, i, 0, 0, m_lat)
        if need_ctx:
            x_ctx = ffn_sub(x_ctx, i, 0, 0, m_ctx)

        if mixer == 0:
            lru_args = (lru_w_in[mi], lru_conv_w[mi], lru_conv_b[mi], lru_wa[mi], lru_ba[mi],
                        lru_wi[mi], lru_bi[mi], lru_lambda[mi], lru_w_out[mi])
            zeros = jnp.zeros((x_ctx.shape[0], D_RNN), jnp.float32)
            yc, hc_f, hc_b = rglru_block(pre(x_ctx, i, 1, m_ctx), *lru_args, zeros, zeros)
            yl, _, _ = rglru_block(pre(x_lat, i, 1, m_lat), *lru_args, hc_f, hc_b)
            x_ctx = post(x_ctx, yc, i, 1, m_ctx, 1.0)
            x_lat = post(x_lat, yl, i, 1, m_lat, 1.0)
        else:
            sgu_args = (sgu_w_in[mi], sgu_b_in[mi], sgu_ln_g[mi], sgu_ln_b[mi], sgu_ws[mi], sgu_bs[mi], sgu_w_out[mi])
            x_lat = post(x_lat, chunk_sgu(pre(x_lat, i, 1, m_lat), *sgu_args), i, 1, m_lat, 1.0)
            if need_ctx:
                x_ctx = post(x_ctx, chunk_sgu(pre(x_ctx, i, 1, m_ctx), *sgu_args), i, 1, m_ctx, 1.0)

        x_lat = ffn_sub(x_lat, i, 2, 1, m_lat)
        if need_ctx and any(j % N_MIXERS == 0 for j in range(i + 1, DEPTH)):
            x_ctx = ffn_sub(x_ctx, i, 2, 1, m_ctx)
    return x_lat
```

```cpp
#include <hip/hip_runtime.h>
#include <hip/hip_cooperative_groups.h>
#include <cstdio>
#include <cstdint>
namespace cg = cooperative_groups;
#ifndef ONE_LAUNCH
#define ONE_LAUNCH 1
#endif
#ifndef PHM
#define PHM 0xffff
#endif
__device__ __forceinline__ int otid() { int t = threadIdx.x; asm volatile("" : "+v"(t)); return t; }
__device__ __forceinline__ int obid() { int b = blockIdx.x; asm volatile("" : "+s"(b)); return b; }
namespace pg8 {
#define PG8_LAS __attribute__((address_space(3)))
typedef unsigned short bf16_t;
typedef short bf16x8 __attribute__((ext_vector_type(8)));
typedef float f32x4 __attribute__((ext_vector_type(4)));
typedef unsigned u32x4 __attribute__((ext_vector_type(4)));
constexpr int BM = 256, BK = 64, HALF = 128, HTB = HALF * BK * 2  , STAGE_BYTES = 8 * HTB, NXCD = 8, WGM = 8;

__host__ __device__ __forceinline__ int lds_byte(int r, int c) { const int st = (r >> 4) * 2 + (c >> 5), rr = r & 15, cc = c & 31, ob = rr * 64 + cc * 2; return st * 1024 + (ob ^ (((ob >> 9) & 1) << 5)); }
__host__ __device__ __forceinline__ void stage_rc(int b, int& R, int& C) { const int st = b / 1024, sb = b % 1024, swz = sb ^ (((sb >> 9) & 1) << 5); R = (st >> 1) * 16 + swz / 64; C = (st & 1) * 32 + (swz % 64) / 2; }
__host__ __device__ __forceinline__ int perm32(int rho) { const int n = rho >> 4, i = rho & 15; return 8 * (i >> 2) + 4 * n + (i & 3); }

struct Unit { int pm, pn; };
struct Gemm { const bf16_t* A; const bf16_t* Bt; int M, N, K, lda; };

struct StaticOrder {
    int nM, nN, nwg, G, c;
    __host__ __device__ void init(int M, int N, int G_, int c_) { nM = M / BM; nN = N / BM; nwg = nM * nN; G = G_; c = c_; }
    __host__ __device__ bool next(int i, Unit& u) const {
        const long L = (long)i * G + c; if (L >= nwg) return false;
        int wgid = (int)L; { const int q = nwg / NXCD, r = nwg % NXCD, xcd = wgid % NXCD, off = wgid / NXCD; wgid = (xcd < r ? xcd * (q + 1) : r * (q + 1) + (xcd - r) * q) + off; }
        const int nig = WGM * nN, gid = wgid / nig, fm = gid * WGM, gsz = (nM - fm) < WGM ? (nM - fm) : WGM;
        u.pm = fm + ((wgid % nig) % gsz); u.pn = (wgid % nig) / gsz; return true;
    }
    __device__ __forceinline__ void a_ready(const Unit&) const {}
    __device__ __forceinline__ void done(const Unit&) const {}
};
__device__ __forceinline__ unsigned cvt_pk_bf16(float lo, float hi) { unsigned r; asm volatile("v_cvt_pk_bf16_f32 %0, %1, %2" : "=v"(r) : "v"(lo), "v"(hi)); return r; }
typedef float f32x2 __attribute__((ext_vector_type(2)));
template <class Epi, class Sched, bool ALIGN_EPI = false, bool SP2 = false>
__device__ __forceinline__ void gemm_phase(PG8_LAS unsigned char* lds, const Gemm g, const Sched& S, const Epi& E) {
    const int tid = otid(), wid = __builtin_amdgcn_readfirstlane(tid >> 6), lane = tid & 63, wr = wid >> 2, wc = wid & 3, fr = lane & 15, fq = lane >> 4;
    const int K = g.K, nt = K / BK;
    unsigned voffA[2], voffB[2];
#pragma unroll
    for (int i = 0; i < 2; ++i) { int R, C; stage_rc(tid * 16 + i * 8192, R, C); const int Rb = Epi::PERM ? ((R & ~31) + perm32(R & 31)) : R;
        voffA[i] = (unsigned)(R * g.lda + C) * 2u; voffB[i] = (unsigned)(Rb * K + C) * 2u; }
    const size_t kstep = (size_t)(BK * 2);
    const size_t hstepB = (size_t)HALF * K * 2, hstepA = (size_t)HALF * g.lda * 2;
    const size_t tstepA = 2 * hstepA, tstepB = 2 * hstepB;
    const unsigned ldsw = (unsigned)wid * 1024u;
    const int aoff = lds_byte(wr * 64 + fr, fq * 8), boff = lds_byte(wc * 32 + fr, fq * 8);
#define PG8_SA(b, h) (((b) * 2 + (h)) * HTB)
#define PG8_SB(b, h) ((4 + (b) * 2 + (h)) * HTB)
#define PG8_STAGE(bufoff, gbase, voff) do { _Pragma("unroll") for (int _i = 0; _i < 2; ++_i) \
        __builtin_amdgcn_global_load_lds((const unsigned*)((const char*)(gbase) + (voff)[_i]), (PG8_LAS unsigned*)(lds + (bufoff) + ldsw + _i * 8192), 16, 0, 0); } while (0)
#define PG8_LDA(dst, b, h) do { _Pragma("unroll") for (int m = 0; m < 4; ++m) _Pragma("unroll") for (int k = 0; k < 2; ++k) dst[m][k] = *(const PG8_LAS bf16x8*)(lds + PG8_SA(b, h) + aoff + m * 2048 + k * 1024); } while (0)
#define PG8_LDB(dst, b, h) do { _Pragma("unroll") for (int n = 0; n < 2; ++n) _Pragma("unroll") for (int k = 0; k < 2; ++k) dst[n][k] = *(const PG8_LAS bf16x8*)(lds + PG8_SB(b, h) + boff + n * 2048 + k * 1024); } while (0)
#define PG8_MMA(ai, bj, At, Bt) do { __builtin_amdgcn_s_setprio(1); _Pragma("unroll") for (int m = 0; m < 4; ++m) _Pragma("unroll") for (int n = 0; n < 2; ++n) _Pragma("unroll") for (int k = 0; k < 2; ++k) \
        acc[ai][bj][m][n] = __builtin_amdgcn_mfma_f32_16x16x32_bf16(Bt[n][k], At[m][k], acc[ai][bj][m][n], 0, 0, 0); __builtin_amdgcn_s_setprio(0); } while (0)
#define PG8_WAIT_V(n) asm volatile("s_waitcnt vmcnt(" #n ")" ::: "memory")
#define PG8_WAIT_L(n) asm volatile("s_waitcnt lgkmcnt(" #n ")" ::: "memory")
#define PG8_BAR __builtin_amdgcn_s_barrier()
#define PG8_SCHED __builtin_amdgcn_sched_barrier(0)
    Unit cur, nxt; int ui = 0;
    if (!S.next(0, cur)) return;
    f32x4 acc[2][2][4][2];
#pragma unroll
    for (int a = 0; a < 2; ++a)
#pragma unroll
        for (int b = 0; b < 2; ++b)
#pragma unroll
            for (int m = 0; m < 4; ++m)
#pragma unroll
                for (int n = 0; n < 2; ++n) acc[a][b][m][n] = (f32x4){0.f, 0.f, 0.f, 0.f};
    bf16x8 At[4][2], B0[2][2], B1[2][2];
    const char* cA = (const char*)g.A + (size_t)cur.pm * tstepA; const char* cB = (const char*)g.Bt + (size_t)cur.pn * tstepB;
    S.a_ready(cur);
    if constexpr (SP2) {
        PG8_STAGE(PG8_SB(0, 0), cB, voffB); PG8_STAGE(PG8_SB(0, 1), cB + hstepB, voffB); PG8_STAGE(PG8_SA(0, 0), cA, voffA); PG8_STAGE(PG8_SA(0, 1), cA + hstepA, voffA);
        if (wr == 1) PG8_BAR;
        PG8_WAIT_V(2); PG8_BAR;
        PG8_STAGE(PG8_SB(1, 0), cB + kstep, voffB); PG8_STAGE(PG8_SA(1, 0), cA + kstep, voffA); PG8_STAGE(PG8_SB(1, 1), cB + hstepB + kstep, voffB);
        PG8_WAIT_V(6); PG8_BAR;
    } else {
        PG8_STAGE(PG8_SB(0, 0), cB, voffB); PG8_STAGE(PG8_SA(0, 0), cA, voffA); PG8_STAGE(PG8_SB(0, 1), cB + hstepB, voffB); PG8_STAGE(PG8_SA(0, 1), cA + hstepA, voffA);
        if (wr == 1) PG8_BAR;
        PG8_WAIT_V(4); PG8_BAR;
        PG8_STAGE(PG8_SB(1, 0), cB + kstep, voffB); PG8_STAGE(PG8_SA(1, 0), cA + kstep, voffA); PG8_STAGE(PG8_SB(1, 1), cB + hstepB + kstep, voffB);
        PG8_WAIT_V(6); PG8_BAR;
    }
    for (;;) {
        const bool has_next = S.next(ui + 1, nxt);
        const char* nA = has_next ? (const char*)g.A + (size_t)nxt.pm * tstepA : cA; const char* nB = has_next ? (const char*)g.Bt + (size_t)nxt.pn * tstepB : cB;
        for (int t = 0; t < nt; t += 2) {
            const bool last = (t == nt - 2);
            const char* a1 = cA + (size_t)(t + 1) * kstep;
            const char* a2 = last ? nA : cA + (size_t)(t + 2) * kstep; const char* b2 = last ? nB : cB + (size_t)(t + 2) * kstep;
            const char* a3 = a2 + kstep; const char* b3 = b2 + kstep;
            if (last && has_next) S.a_ready(nxt);
            if constexpr (SP2) {
            PG8_LDB(B0, 0, 0); PG8_LDB(B1, 0, 1); PG8_SCHED; PG8_LDA(At, 0, 0); PG8_STAGE(PG8_SA(1, 1), a1 + hstepA, voffA);
            PG8_WAIT_V(8); PG8_WAIT_L(0); PG8_BAR; PG8_MMA(0, 0, At, B0); PG8_MMA(0, 1, At, B1); PG8_BAR; PG8_SCHED;
            PG8_LDA(At, 0, 1); PG8_STAGE(PG8_SB(0, 0), b2, voffB); PG8_STAGE(PG8_SB(0, 1), b2 + hstepB, voffB); PG8_STAGE(PG8_SA(0, 0), a2, voffA);
            PG8_WAIT_V(8); PG8_WAIT_L(0); PG8_BAR; PG8_MMA(1, 0, At, B0); PG8_MMA(1, 1, At, B1); PG8_BAR; PG8_SCHED;
            PG8_LDB(B0, 1, 0); PG8_LDB(B1, 1, 1); PG8_SCHED; PG8_LDA(At, 1, 0); PG8_STAGE(PG8_SA(0, 1), a2 + hstepA, voffA);
            PG8_WAIT_V(8); PG8_WAIT_L(0); PG8_BAR; PG8_MMA(0, 0, At, B0); PG8_MMA(0, 1, At, B1); PG8_BAR; PG8_SCHED;
            PG8_LDA(At, 1, 1); PG8_STAGE(PG8_SB(1, 0), b3, voffB); PG8_STAGE(PG8_SB(1, 1), b3 + hstepB, voffB); PG8_STAGE(PG8_SA(1, 0), a3, voffA);
            PG8_WAIT_V(8); PG8_WAIT_L(0); PG8_BAR; PG8_MMA(1, 0, At, B0); PG8_MMA(1, 1, At, B1); PG8_BAR; PG8_SCHED;
            } else {
            PG8_LDB(B0, 0, 0); PG8_SCHED; PG8_LDA(At, 0, 0); PG8_STAGE(PG8_SA(1, 1), a1 + hstepA, voffA);
            PG8_WAIT_L(8); PG8_BAR; PG8_WAIT_L(0); PG8_MMA(0, 0, At, B0); PG8_BAR; PG8_SCHED;
            PG8_LDB(B1, 0, 1); PG8_STAGE(PG8_SB(0, 0), b2, voffB);
            PG8_BAR; PG8_WAIT_L(0); PG8_MMA(0, 1, At, B1); PG8_BAR;
            PG8_LDA(At, 0, 1); PG8_STAGE(PG8_SA(0, 0), a2, voffA);
            PG8_BAR; PG8_WAIT_L(0); PG8_MMA(1, 0, At, B0); PG8_BAR; PG8_SCHED;
            PG8_STAGE(PG8_SB(0, 1), b2 + hstepB, voffB);
            PG8_WAIT_V(6); PG8_BAR; PG8_MMA(1, 1, At, B1); PG8_BAR;
            PG8_LDB(B0, 1, 0); PG8_SCHED; PG8_LDA(At, 1, 0); PG8_STAGE(PG8_SA(0, 1), a2 + hstepA, voffA);
            PG8_WAIT_L(8); PG8_BAR; PG8_WAIT_L(0); PG8_MMA(0, 0, At, B0); PG8_BAR; PG8_SCHED;
            PG8_LDB(B1, 1, 1); PG8_STAGE(PG8_SB(1, 0), b3, voffB);
            PG8_BAR; PG8_WAIT_L(0); PG8_MMA(0, 1, At, B1); PG8_BAR;
            PG8_LDA(At, 1, 1); PG8_STAGE(PG8_SA(1, 0), a3, voffA);
            PG8_BAR; PG8_WAIT_L(0); PG8_MMA(1, 0, At, B0); PG8_BAR; PG8_SCHED;
            PG8_STAGE(PG8_SB(1, 1), b3 + hstepB, voffB);
            PG8_WAIT_V(6); PG8_BAR; PG8_MMA(1, 1, At, B1); PG8_BAR;
            }
        }
        if constexpr (ALIGN_EPI) { if (wr == 0) PG8_BAR; }
        if constexpr (!Epi::AFTER_DRAIN) { E(acc, cur, wr, wc, fr, fq); S.done(cur); }
        if (!has_next) break;
#pragma unroll
        for (int a = 0; a < 2; ++a)
#pragma unroll
            for (int b = 0; b < 2; ++b)
#pragma unroll
                for (int m = 0; m < 4; ++m)
#pragma unroll
                    for (int n = 0; n < 2; ++n) acc[a][b][m][n] = (f32x4){0.f, 0.f, 0.f, 0.f};
        cur = nxt; cA = nA; cB = nB; ++ui;
        if constexpr (ALIGN_EPI) { if (wr == 1) PG8_BAR; }
    }
    PG8_WAIT_V(0);
    if constexpr (!ALIGN_EPI) { if (wr == 0) PG8_BAR; }
    PG8_BAR;
    if constexpr (Epi::AFTER_DRAIN) { E.fused(acc, cur, wr, wc, fr, fq, lds, wid, lane); S.done(cur); }
#undef PG8_SA
#undef PG8_SB
#undef PG8_STAGE
#undef PG8_LDA
#undef PG8_LDB
#undef PG8_MMA
#undef PG8_WAIT_V
#undef PG8_WAIT_L
#undef PG8_BAR
#undef PG8_SCHED
}
}

#define LAS __attribute__((address_space(3)))
typedef unsigned short bf16_t;
typedef short bf16x8 __attribute__((ext_vector_type(8)));
typedef float f32x4 __attribute__((ext_vector_type(4)));
typedef float f32x2 __attribute__((ext_vector_type(2)));
typedef unsigned u32x4 __attribute__((ext_vector_type(4)));
typedef unsigned u32x2 __attribute__((ext_vector_type(2)));

constexpr int D = 1024, NB = 8, SEQ = 8192, NLAT = NB * SEQ, CTXL = 256, NCTX = NB * CTXL, MT = NLAT + NCTX;
constexpr int DFF = 2816, NUP = 2 * DFF, DSGU = 2048, NSLOT = 66;
constexpr float EPS = 1e-6f;
constexpr int NTHR = 512, NWAVES = 8;
constexpr int LDS_BYTES = 147456;
constexpr int NPHASE = 24;

constexpr size_t MiB = 1u << 20;
constexpr size_t WS_X16 = 360 * MiB;
constexpr size_t WS_CTL = 0, WS_MOD = 1 * MiB, WS_XC = 2 * MiB, WS_WG = 10 * MiB, WS_WSB = 11 * MiB, WS_WUP = 12 * MiB, WS_WDN = 56 * MiB, WS_LIN = 78 * MiB,
                 WS_LOUT = 82 * MiB, WS_SIN = 84 * MiB, WS_SOUT = 92 * MiB, WS_H = 96 * MiB, WS_Y = 228 * MiB, WS_G = 492 * MiB, WS_SUM = 1004 * MiB,
                 WS_HIN = 1013 * MiB, WS_END = 1018 * MiB;

struct Params;
typedef const __attribute__((address_space(4))) Params* CP;
struct Params {
    const float* in[27];
    float* out;
    unsigned char* ws;
    int ph_lo, ph_hi;
};

__device__ __forceinline__ unsigned f2bf(float f) { unsigned u = __builtin_bit_cast(unsigned, f); return (u + 0x7fffu + ((u >> 16) & 1u)) >> 16; }
__device__ __forceinline__ unsigned pk2(float lo, float hi) { return pg8::cvt_pk_bf16(lo, hi); }
__device__ __forceinline__ float bf_lo(unsigned w) { return __builtin_bit_cast(float, w << 16); }
__device__ __forceinline__ float bf_hi(unsigned w) { return __builtin_bit_cast(float, w & 0xffff0000u); }
typedef _Float16 h16x2 __attribute__((ext_vector_type(2)));
__device__ __forceinline__ unsigned pk2h(float lo, float hi) { h16x2 v; v.x = (_Float16)lo; v.y = (_Float16)hi; return __builtin_bit_cast(unsigned, v); }
__device__ __forceinline__ float h_lo(unsigned w) { return (float)__builtin_bit_cast(h16x2, w).x; }
__device__ __forceinline__ float h_hi(unsigned w) { return (float)__builtin_bit_cast(h16x2, w).y; }
__device__ __forceinline__ float fast_exp(float x) { return __builtin_amdgcn_exp2f(x * 1.4426950408889634f); }
__device__ __forceinline__ float sigmoidf_(float x) { return __builtin_amdgcn_rcpf(1.0f + fast_exp(-x)); }
__device__ __forceinline__ float siluf_(float x) { return x * sigmoidf_(x); }
__device__ __forceinline__ float gelu_tanh(float x) { const float u = 1.5957691216057308f * (x + 0.044715f * x * x * x); return x * sigmoidf_(u); }
__device__ __forceinline__ float wave_sum(float v) {
#pragma unroll
    for (int o = 1; o < 64; o <<= 1) v += __shfl_xor(v, o);
    return v;
}

struct EpiSwiglu {
    static constexpr bool PERM = true, AFTER_DRAIN = false;
    bf16_t* O; int ldc;
    __device__ __forceinline__ void operator()(const f32x4 (&acc)[2][2][4][2], const pg8::Unit& u, int wr, int wc, int fr, int fq) const {
        const int row0 = u.pm * 256 + wr * 64 + fr, col0 = u.pn * 128 + wc * 32 + 8 * fq;
#pragma unroll
        for (int ai = 0; ai < 2; ++ai)
#pragma unroll
            for (int m = 0; m < 4; ++m) {
                bf16_t* rowp = O + (size_t)(row0 + ai * 128 + m * 16) * ldc + col0;
                const f32x4 a0 = acc[ai][0][m][0], a1 = acc[ai][0][m][1], g0 = acc[ai][1][m][0], g1 = acc[ai][1][m][1];
                u32x4 w;
                w.x = pk2(siluf_(a0[0]) * g0[0], siluf_(a0[1]) * g0[1]); w.y = pk2(siluf_(a0[2]) * g0[2], siluf_(a0[3]) * g0[3]);
                w.z = pk2(siluf_(a1[0]) * g1[0], siluf_(a1[1]) * g1[1]); w.w = pk2(siluf_(a1[2]) * g1[2], siluf_(a1[3]) * g1[3]);
                *(u32x4*)rowp = w;
            }
    }
};
struct EpiF32 {
    static constexpr bool PERM = false, AFTER_DRAIN = false;
    float* C; int ldc;
    __device__ __forceinline__ void operator()(const f32x4 (&acc)[2][2][4][2], const pg8::Unit& u, int wr, int wc, int fr, int fq) const {
        const int row0 = u.pm * 256 + wr * 64 + fr, col0 = u.pn * 256 + wc * 32 + 4 * fq;
#pragma unroll
        for (int ai = 0; ai < 2; ++ai)
#pragma unroll
            for (int m = 0; m < 4; ++m) { float* rowp = C + (size_t)(row0 + ai * 128 + m * 16) * ldc + col0;
#pragma unroll
                for (int bj = 0; bj < 2; ++bj)
#pragma unroll
                    for (int n = 0; n < 2; ++n) *(f32x4*)(rowp + bj * 128 + n * 16) = acc[ai][bj][m][n]; }
    }
};
struct EpiAct {
    static constexpr bool PERM = true, AFTER_DRAIN = false;
    bf16_t* O; int ldc; const float* bias; int gelu_tiles; int stat_tile0; f32x2* STAT;
    __device__ __forceinline__ void operator()(const f32x4 (&acc)[2][2][4][2], const pg8::Unit& u, int wr, int wc, int fr, int fq) const {
        const int row0 = u.pm * 256 + wr * 64 + fr, col0 = u.pn * 256 + wc * 32 + 8 * fq;
        const bool do_gelu = u.pn < gelu_tiles, do_stat = u.pn >= stat_tile0;
        f32x4 bv[2][2];
#pragma unroll
        for (int bj = 0; bj < 2; ++bj)
#pragma unroll
            for (int n = 0; n < 2; ++n) bv[bj][n] = bias ? *(const f32x4*)(bias + col0 + bj * 128 + 4 * n) : (f32x4){0.f, 0.f, 0.f, 0.f};
#pragma unroll
        for (int ai = 0; ai < 2; ++ai)
#pragma unroll
            for (int m = 0; m < 4; ++m) {
                const int row = row0 + ai * 128 + m * 16;
                bf16_t* rowp = O + (size_t)row * ldc + col0;
                float s = 0.f, ss = 0.f;
#pragma unroll
                for (int bj = 0; bj < 2; ++bj) {
                    f32x4 v0 = acc[ai][bj][m][0] + bv[bj][0], v1 = acc[ai][bj][m][1] + bv[bj][1];
                    if (do_gelu) {
#pragma unroll
                        for (int e = 0; e < 4; ++e) { v0[e] = gelu_tanh(v0[e]); v1[e] = gelu_tanh(v1[e]); }
                    }
#pragma unroll
                    for (int e = 0; e < 4; ++e) { s += v0[e] + v1[e]; ss += v0[e] * v0[e] + v1[e] * v1[e]; }
                    u32x4 w; w.x = pk2(v0[0], v0[1]); w.y = pk2(v0[2], v0[3]); w.z = pk2(v1[0], v1[1]); w.w = pk2(v1[2], v1[3]);
                    *(u32x4*)(rowp + bj * 128) = w;
                }
                if (do_stat) {
                    s += __shfl_xor(s, 16); s += __shfl_xor(s, 32); ss += __shfl_xor(ss, 16); ss += __shfl_xor(ss, 32);
                    if (fq == 0) STAT[(size_t)row * 32 + (u.pn - stat_tile0) * 4 + wc] = (f32x2){s, ss};
                }
            }
    }
};

__device__ __forceinline__ void transpose_tile64(const float* W, int K, int N, bf16_t* WT, int k0, int n0, int drow0, LAS float* scr, int lane, float scale = 1.0f) {
    const int lr = lane >> 4, lc = (lane & 15) * 4;
    f32x4 v[16];
#pragma unroll
    for (int i = 0; i < 16; ++i) v[i] = *(const f32x4*)(W + (size_t)(k0 + 4 * i + lr) * N + n0 + lc);
#pragma unroll
    for (int i = 0; i < 16; ++i) { LAS float* d = scr + (4 * i + lr) * 65 + lc; d[0] = v[i][0] * scale; d[1] = v[i][1] * scale; d[2] = v[i][2] * scale; d[3] = v[i][3] * scale; }
    asm volatile("s_waitcnt lgkmcnt(0)" ::: "memory");
    const int c = lane & 7;
#pragma unroll
    for (int j = 0; j < 8; ++j) { const int n = (lane >> 3) + 8 * j; const LAS float* s = scr + (8 * c) * 65 + n;
        u32x4 o; o.x = pk2(s[0 * 65], s[1 * 65]); o.y = pk2(s[2 * 65], s[3 * 65]); o.z = pk2(s[4 * 65], s[5 * 65]); o.w = pk2(s[6 * 65], s[7 * 65]);
        *(u32x4*)(WT + (size_t)(drow0 + n) * K + k0 + 8 * c) = o; }
    asm volatile("s_waitcnt lgkmcnt(0)" ::: "memory");
}

__device__ __forceinline__ void phase_prep(CP pp, LAS unsigned char* lds) {
    const int tid = otid(), lane = tid & 63, wave = tid >> 6;
    unsigned char* ws = pp->ws;
    if ((int)obid() < 144) {
        LAS float* S = (LAS float*)lds;
        LAS float* RED = S + 9 * 1024;
        const float* c = pp->in[1]; const float* cctx = pp->in[3]; const float* ada_w = pp->in[4]; const float* ada_b = pp->in[5];
        float* MOD = (float*)(ws + WS_MOD);
        for (int idx = tid; idx < 9 * 1024; idx += NTHR) { const int r = idx >> 10, k = idx & 1023; const float v = r < 8 ? c[r * 1024 + k] : cctx[k]; S[idx] = siluf_(v); }
        __syncthreads();
        for (int item = obid(); item < 144; item += gridDim.x) {
            const int layer = item / 72, n0 = (item % 72) * 128;
            const int half = lane >> 5, l32 = lane & 31;
            const float* W = ada_w + (size_t)layer * 1024 * 9216 + (size_t)(wave * 128 + half) * 9216 + n0 + 4 * l32;
            f32x4 acc[9];
#pragma unroll
            for (int r = 0; r < 9; ++r) acc[r] = (f32x4){0.f, 0.f, 0.f, 0.f};
#pragma unroll 1
            for (int ib = 0; ib < 4; ++ib) {
                f32x4 wv[16];
#pragma unroll
                for (int i = 0; i < 16; ++i) wv[i] = *(const f32x4*)(W + (size_t)(2 * (16 * ib + i)) * 9216);
#pragma unroll
                for (int i = 0; i < 16; ++i) { const int k = wave * 128 + 2 * (16 * ib + i) + half;
#pragma unroll
                    for (int r = 0; r < 9; ++r) acc[r] += wv[i] * S[r * 1024 + k]; }
            }
#pragma unroll
            for (int r = 0; r < 9; ++r)
#pragma unroll
                for (int e = 0; e < 4; ++e) acc[r][e] += __shfl_xor(acc[r][e], 32);
            if (half == 0) {
#pragma unroll
                for (int r = 0; r < 9; ++r) *(LAS f32x4*)(RED + (wave * 9 + r) * 128 + 4 * l32) = acc[r];
            }
            __syncthreads();
            for (int idx = tid; idx < 9 * 128; idx += NTHR) { const int r = idx >> 7, l = idx & 127; float s = 0.f;
#pragma unroll
                for (int w = 0; w < 8; ++w) s += RED[(w * 9 + r) * 128 + l];
                MOD[(size_t)(layer * 9 + r) * 9216 + n0 + l] = s + ada_b[layer * 9216 + n0 + l]; }
            __syncthreads();
        }
    }
    {
        LAS float* scr = (LAS float*)(lds + wave * 16640);
        const int gw = obid() * NWAVES + wave, NGW = gridDim.x * NWAVES;
        constexpr int I_FFN = 704, I_LIN = 512, I_LOUT = 256, I_SIN = 1024, I_SOUT = 512, I_G = 128;
        constexpr int NITEMS = 12 * I_FFN + I_LIN + I_LOUT + I_SIN + I_SOUT + I_G;
        for (int it = gw; it < NITEMS; it += NGW) {
            int r = it;
            if (r < 12 * I_FFN) {
                const int mat = r / I_FFN, sub = r % I_FFN, idx = mat / 3, kind = mat % 3;
                if (kind < 2) {
                    const float* W = pp->in[kind == 0 ? 8 : 9] + (size_t)idx * 1024 * DFF;
                    const int nblk = DFF / 64, kb = sub / nblk, nb = sub % nblk, n0 = nb * 64;
                    transpose_tile64(W, 1024, DFF, (bf16_t*)(ws + WS_WUP) + (size_t)idx * NUP * 1024, kb * 64, n0, (n0 >> 7) * 256 + kind * 128 + (n0 & 127), scr, lane);
                } else {
                    const float* W = pp->in[10] + (size_t)idx * DFF * 1024;
                    const int nblk = 1024 / 64, kb = sub / nblk, nb = sub % nblk;
                    transpose_tile64(W, DFF, 1024, (bf16_t*)(ws + WS_WDN) + (size_t)idx * 1024 * DFF, kb * 64, nb * 64, nb * 64, scr, lane);
                }
                continue;
            }
            r -= 12 * I_FFN;
            if (r < I_LIN) { const int nblk = 2048 / 64; transpose_tile64(pp->in[11], 1024, 2048, (bf16_t*)(ws + WS_LIN), (r / nblk) * 64, (r % nblk) * 64, (r % nblk) * 64, scr, lane); continue; }
            r -= I_LIN;
            if (r < I_LOUT) { const int nblk = 1024 / 64; transpose_tile64(pp->in[19], 1024, 1024, (bf16_t*)(ws + WS_LOUT), (r / nblk) * 64, (r % nblk) * 64, (r % nblk) * 64, scr, lane); continue; }
            r -= I_LOUT;
            if (r < I_SIN) { const int nblk = 4096 / 64; transpose_tile64(pp->in[20], 1024, 4096, (bf16_t*)(ws + WS_SIN), (r / nblk) * 64, (r % nblk) * 64, (r % nblk) * 64, scr, lane); continue; }
            r -= I_SIN;
            if (r < I_SOUT) { const int nblk = 1024 / 64; transpose_tile64(pp->in[26], 2048, 1024, (bf16_t*)(ws + WS_SOUT), (r / nblk) * 64, (r % nblk) * 64, (r % nblk) * 64, scr, lane); continue; }
            r -= I_SOUT;
            {
                const int mat = r >> 2, sub = r & 3, gate = mat >> 4, dir = (mat >> 3) & 1, head = mat & 7;
                const float* W = pp->in[gate == 0 ? 14 : 16] + (size_t)(dir * 8 + head) * 128 * 128;
                bf16_t* WT = (bf16_t*)(ws + WS_WG) + (size_t)((head * 4 + dir * 2 + gate) * 128) * 128;
                transpose_tile64(W, 128, 128, WT, (sub >> 1) * 64, (sub & 1) * 64, (sub & 1) * 64, scr, lane, -1.4426950408889634f);
            }
        }
        { const float* W = pp->in[24]; unsigned* O = (unsigned*)(ws + WS_WSB);
          for (int i = obid() * NTHR + tid; i < 8 * 128 * 128 / 2; i += gridDim.x * NTHR) O[i] = pk2(W[2 * i], W[2 * i + 1]); }
    }
}

__device__ __forceinline__ void rows_one(CP pp, int mode, int r, int has_pre, const f32x4 (&gg)[4], const f32x4 (&pa)[4], const f32x4 (&pb)[4], int lane) {
    u32x2* xrow = (u32x2*)((unsigned short*)(pp->ws + WS_X16) + (size_t)r * D) + lane;
    f32x4 v[4];
    if (mode == 0) {
        if (r < NLAT) {
            const f32x4* xr = (const f32x4*)(pp->in[0] + (size_t)r * D) + lane;
            const int t = r & (SEQ - 1); const float prow = (float)(t >> 6), pcol = (float)(t & 63);
#pragma unroll
            for (int j = 0; j < 4; ++j) v[j] = __builtin_nontemporal_load(xr + 64 * j);
#pragma unroll
            for (int e = 0; e < 4; ++e) {
                const float om = __builtin_amdgcn_exp2f(-(float)(4 * lane + e) * (13.287712379549449f / 256.0f));
                float ar = prow * om * 0.15915494309189535f, ac = pcol * om * 0.15915494309189535f;
                ar -= __builtin_rintf(ar); ac -= __builtin_rintf(ac);
                v[0][e] += __builtin_amdgcn_sinf(ar); v[1][e] += __builtin_amdgcn_cosf(ar);
                v[2][e] += __builtin_amdgcn_sinf(ac); v[3][e] += __builtin_amdgcn_cosf(ac);
            }
        } else {
            const f32x4* xr = (const f32x4*)(pp->in[2] + (size_t)(r - NLAT) * D) + lane;
#pragma unroll
            for (int j = 0; j < 4; ++j) v[j] = __builtin_nontemporal_load(xr + 64 * j);
        }
    } else {
        const u32x2* yr = (const u32x2*)((const bf16_t*)(pp->ws + WS_Y) + (size_t)r * D) + lane;
        f32x4 y[4]; float ss = 0.f;
#pragma unroll
        for (int j = 0; j < 4; ++j) { const u32x2 w = __builtin_nontemporal_load(yr + 64 * j); const u32x2 xw_ = __builtin_nontemporal_load(xrow + 64 * j); v[j] = (f32x4){h_lo(xw_.x), h_hi(xw_.x), h_lo(xw_.y), h_hi(xw_.y)}; y[j] = (f32x4){bf_lo(w.x), bf_hi(w.x), bf_lo(w.y), bf_hi(w.y)}; ss += (y[j][0] * y[j][0] + y[j][1] * y[j][1]) + (y[j][2] * y[j][2] + y[j][3] * y[j][3]); }
        const float rstd = 1.0f / sqrtf(wave_sum(ss) * (1.0f / D) + EPS);
#pragma unroll
        for (int j = 0; j < 4; ++j) v[j] = v[j] + gg[j] * (y[j] * rstd);
    }
    if (has_pre) {
#pragma unroll
        for (int j = 0; j < 4; ++j) { u32x2 w; w.x = pk2h(v[j][0], v[j][1]); w.y = pk2h(v[j][2], v[j][3]); __builtin_nontemporal_store(w, xrow + 64 * j); }
    } else {
        f32x4* xw = (f32x4*)(pp->out + (size_t)r * D) + lane;
#pragma unroll
        for (int j = 0; j < 4; ++j) __builtin_nontemporal_store(v[j], xw + 64 * j);
    }
    if (has_pre) {
        float ss = 0.f;
#pragma unroll
        for (int j = 0; j < 4; ++j) ss += (v[j][0] * v[j][0] + v[j][1] * v[j][1]) + (v[j][2] * v[j][2] + v[j][3] * v[j][3]);
        const float rstd = 1.0f / sqrtf(wave_sum(ss) * (1.0f / D) + EPS);
        u32x2* ho = (u32x2*)((bf16_t*)(pp->ws + WS_H) + (size_t)r * D) + lane;
#pragma unroll
        for (int j = 0; j < 4; ++j) { const f32x4 h = (v[j] * rstd) * pa[j] + pb[j]; u32x2 w; w.x = pk2(h[0], h[1]); w.y = pk2(h[2], h[3]); __builtin_nontemporal_store(w, ho + 64 * j); }
    }
}
__device__ __forceinline__ void rows_vectors(CP pp, int mode, int modrow, int li, int k, float wgt, int has_pre, int li2, int k2, f32x4 (&gg)[4], f32x4 (&pa)[4], f32x4 (&pb)[4], int lane) {
    const float* MOD = (const float*)(pp->ws + WS_MOD);
#pragma unroll
    for (int j = 0; j < 4; ++j) { gg[j] = (f32x4){0.f, 0.f, 0.f, 0.f}; pa[j] = gg[j]; pb[j] = gg[j]; }
    if (mode == 1) {
        const f32x4* gate = (const f32x4*)(MOD + (size_t)(li * 9 + modrow) * 9216 + (3 * k + 2) * 1024) + lane;
        const f32x4* gp = (const f32x4*)(pp->in[7] + (size_t)(li * 3 + k) * 1024) + lane;
#pragma unroll
        for (int j = 0; j < 4; ++j) gg[j] = gate[64 * j] * gp[64 * j] * wgt;
    }
    if (has_pre) {
        const f32x4* g = (const f32x4*)(pp->in[6] + (size_t)(li2 * 3 + k2) * 1024) + lane;
        const f32x4* sh = (const f32x4*)(MOD + (size_t)(li2 * 9 + modrow) * 9216 + (3 * k2) * 1024) + lane;
        const f32x4* sc = (const f32x4*)(MOD + (size_t)(li2 * 9 + modrow) * 9216 + (3 * k2 + 1) * 1024) + lane;
#pragma unroll
        for (int j = 0; j < 4; ++j) { pa[j] = g[64 * j] * (sc[64 * j] + 1.0f); pb[j] = sh[64 * j]; }
    }
}
__device__ __forceinline__ void phase_rows(CP pp, int mode, int rows, int li, int k, float wgt, int has_pre, int li2, int k2) {
    const int tid = otid(), lane = tid & 63, wave = tid >> 6;
    const int gw = obid() * NWAVES + wave, NGW = gridDim.x * NWAVES, WPB = NGW / NB;
    f32x4 gg[4], pa[4], pb[4];
    {
        const int b = gw / WPB, wi = gw % WPB;
        rows_vectors(pp, mode, b, li, k, wgt, has_pre, li2, k2, gg, pa, pb, lane);
        for (int i = wi; i < SEQ; i += WPB) rows_one(pp, mode, b * SEQ + i, has_pre, gg, pa, pb, lane);
    }
    if (rows > NLAT) {
        rows_vectors(pp, mode, 8, li, k, wgt, has_pre, li2, k2, gg, pa, pb, lane);
        for (int rc = gw; rc < NCTX; rc += NGW) rows_one(pp, mode, NLAT + rc, has_pre, gg, pa, pb, lane);
    }
}

template <int PASS>
__device__ __forceinline__ void lru_pass(CP pp, LAS unsigned char* lds) {
    LAS float* XCF = (LAS float*)lds;
    LAS unsigned char* XCB = lds + 67584;
    LAS unsigned char* GBT = lds + 67584 + 34816;
    const int tid = otid(), lane = tid & 63, wave = tid >> 6, fr = lane & 15, fq = lane >> 4;
    bf16_t* Zl = (bf16_t*)(pp->ws + WS_G);
    const bf16_t* Wg = (const bf16_t*)(pp->ws + WS_WG);
    f32x2* SUM = (f32x2*)(pp->ws + WS_SUM);
    const float* HIN = (const float*)(pp->ws + WS_HIN);
    const float* conv_w = pp->in[12]; const float* conv_b = pp->in[13];
    const int nitems = PASS == 1 ? NB * NSLOT * 8 : NB * 64 * 8;
    for (int item = obid(); item < nitems; item += gridDim.x) {
        const int head = item & 7, rest = item >> 3;
        int b, slot;
        if (PASS == 1) { b = rest / NSLOT; slot = rest % NSLOT; } else { b = rest >> 6; slot = 2 + (rest & 63); }
        int rowbase, t0, L;
        if (slot < 2) { rowbase = NLAT + b * CTXL; t0 = slot * 128; L = CTXL; } else { rowbase = b * SEQ; t0 = (slot - 2) * 128; L = SEQ; }
        {
            const int ch = 2 * lane, gch = head * 128 + ch;
            const f32x2 w0 = *(const f32x2*)(conv_w + 0 * 1024 + gch), w1 = *(const f32x2*)(conv_w + 1 * 1024 + gch), w2 = *(const f32x2*)(conv_w + 2 * 1024 + gch),
                        w3 = *(const f32x2*)(conv_w + 3 * 1024 + gch), cb = *(const f32x2*)(conv_b + gch);
            const int tb = t0 + wave * 16;
            const unsigned* src = (const unsigned*)(Zl + (size_t)rowbase * 2048 + 1024 + gch);
            unsigned raw[19];
#pragma unroll
            for (int i = 0; i < 19; ++i) { const int t = tb - 2 + i; raw[i] = (t >= 0 && t < L) ? src[(size_t)t * 1024] : 0u; }
#pragma unroll
            for (int it = 0; it < 16; ++it) {
                const float x = w0.x * bf_lo(raw[it]) + w1.x * bf_lo(raw[it + 1]) + w2.x * bf_lo(raw[it + 2]) + w3.x * bf_lo(raw[it + 3]) + cb.x;
                const float y = w0.y * bf_hi(raw[it]) + w1.y * bf_hi(raw[it + 1]) + w2.y * bf_hi(raw[it + 2]) + w3.y * bf_hi(raw[it + 3]) + cb.y;
                const int tt = wave * 16 + it;
                *(LAS f32x2*)(XCF + tt * 132 + ch) = (f32x2){x, y};
                *(LAS unsigned*)(XCB + tt * 272 + ch * 2) = pk2(x, y);
            }
            if (PASS == 2) {
#pragma unroll
                for (int it = 0; it < 4; ++it) { const int id = it * NTHR + tid, row = id >> 4, pc = id & 15;
                    *(LAS u32x4*)(GBT + row * 272 + pc * 16) = __builtin_nontemporal_load((const u32x4*)(Zl + (size_t)(rowbase + t0 + row) * 2048 + head * 128 + pc * 8)); }
            }
        }
        __syncthreads();
        {
            const int chw = wave * 16 + fr, gch = head * 128 + chw;
            float hf[8][4];
#pragma unroll
            for (int dir = 0; dir < 2; ++dir) {
                bf16x8 Bf[2][4];
#pragma unroll
                for (int g2 = 0; g2 < 2; ++g2)
#pragma unroll
                    for (int ks = 0; ks < 4; ++ks) Bf[g2][ks] = *(const bf16x8*)(Wg + (size_t)((head * 4 + dir * 2 + g2) * 128 + chw) * 128 + 32 * ks + 8 * fq);
                const float ba = -1.4426950408889634f * pp->in[15][dir * 1024 + gch], bi = -1.4426950408889634f * pp->in[17][dir * 1024 + gch];
                const float lam = pp->in[18][dir * 1024 + gch];
                const float ex = fast_exp(-fmaxf(lam, -20.f));
                const float sp = ex < 0.03f ? ex * (1.0f + ex * (-0.5f + ex * (0.33333333f + ex * (-0.25f + ex * 0.2f))))
                                            : (lam < -20.f ? -lam : __builtin_amdgcn_logf(1.0f + ex) * 0.6931471805599453f);
                const float c8 = 8.0f * sp * 1.4426950408889634f;
                float hcarry = 0.f, Achunk = 1.f;
                if (PASS == 2) hcarry = HIN[(size_t)((dir * NB + b) * NSLOT + slot) * 1024 + gch];
#pragma unroll
                for (int mi = 0; mi < 8; ++mi) {
                    const int m = dir == 0 ? mi : 7 - mi;
                    f32x4 acc0 = {ba, ba, ba, ba}, acc1 = {bi, bi, bi, bi};
#pragma unroll
                    for (int ks = 0; ks < 4; ++ks) {
                        const bf16x8 Af = *(const LAS bf16x8*)(XCB + (16 * m + fr) * 272 + (32 * ks + 8 * fq) * 2);
                        acc0 = __builtin_amdgcn_mfma_f32_16x16x32_bf16(Af, Bf[0][ks], acc0, 0, 0, 0);
                        acc1 = __builtin_amdgcn_mfma_f32_16x16x32_bf16(Af, Bf[1][ks], acc1, 0, 0, 0);
                    }
                    float a[4], bb[4];
#pragma unroll
                    for (int r = 0; r < 4; ++r) {
                        const int tok = 16 * m + 4 * fq + r;
                        const float xc = XCF[tok * 132 + chw];
                        const float rg = __builtin_amdgcn_rcpf(1.0f + __builtin_amdgcn_exp2f(acc0[r])), ig = __builtin_amdgcn_rcpf(1.0f + __builtin_amdgcn_exp2f(acc1[r]));
                        a[r] = __builtin_amdgcn_exp2f(-rg * c8);
                        bb[r] = __builtin_amdgcn_sqrtf(fmaxf(__builtin_fmaf(-a[r], a[r], 1.0f), 0.f)) * (ig * xc);
                    }
                    float Al, Bl;
                    if (dir == 0) { Al = (a[0] * a[1]) * (a[2] * a[3]); Bl = ((bb[0] * a[1] + bb[1]) * a[2] + bb[2]) * a[3] + bb[3]; }
                    else          { Al = (a[0] * a[1]) * (a[2] * a[3]); Bl = ((bb[3] * a[2] + bb[2]) * a[1] + bb[1]) * a[0] + bb[0]; }
                    {
                        float Ap = dir == 0 ? __shfl_up(Al, 16) : __shfl_down(Al, 16), Bp = dir == 0 ? __shfl_up(Bl, 16) : __shfl_down(Bl, 16);
                        const bool ok1 = dir == 0 ? (fq >= 1) : (fq <= 2);
                        if (ok1) { Bl = Al * Bp + Bl; Al = Al * Ap; }
                        Ap = dir == 0 ? __shfl_up(Al, 32) : __shfl_down(Al, 32); Bp = dir == 0 ? __shfl_up(Bl, 32) : __shfl_down(Bl, 32);
                        const bool ok2 = dir == 0 ? (fq >= 2) : (fq <= 1);
                        if (ok2) { Bl = Al * Bp + Bl; Al = Al * Ap; }
                    }
                    const int srcl = dir == 0 ? 48 + fr : fr;
                    const float At = __shfl(Al, srcl), Bt = __shfl(Bl, srcl);
                    if (PASS == 2) {
                        float Ae = dir == 0 ? __shfl_up(Al, 16) : __shfl_down(Al, 16), Be = dir == 0 ? __shfl_up(Bl, 16) : __shfl_down(Bl, 16);
                        const bool first = dir == 0 ? (fq == 0) : (fq == 3);
                        if (first) { Ae = 1.f; Be = 0.f; }
                        float h = Ae * hcarry + Be;
#pragma unroll
                        for (int rr = 0; rr < 4; ++rr) {
                            const int r = dir == 0 ? rr : 3 - rr;
                            h = a[r] * h + bb[r];
                            if (dir == 0) hf[m][r] = h;
                            else {
                                const int tok = 16 * m + 4 * fq + r;
                                LAS unsigned short* gp = (LAS unsigned short*)(GBT + tok * 272 + chw * 2);
                                const float gb = __builtin_bit_cast(float, ((unsigned)*gp) << 16);
                                *gp = (unsigned short)pk2((hf[m][r] + h) * gb, 0.f);
                            }
                        }
                    }
                    hcarry = At * hcarry + Bt; Achunk *= At;
                    asm volatile("" ::: "memory");
                }
                if (PASS == 1) { if (fq == 0) SUM[(size_t)((dir * NB + b) * NSLOT + slot) * 1024 + gch] = (f32x2){Achunk, hcarry}; }
            }
        }
        __syncthreads();
        if (PASS == 2) {
#pragma unroll
            for (int it = 0; it < 4; ++it) { const int id = it * NTHR + tid, row = id >> 4, pc = id & 15;
                *(u32x4*)(Zl + (size_t)(rowbase + t0 + row) * 2048 + head * 128 + pc * 8) = *(const LAS u32x4*)(GBT + row * 272 + pc * 16); }
            __syncthreads();
        }
    }
}

__device__ __forceinline__ void lru_carry(CP pp) {
    const f32x2* SUM = (const f32x2*)(pp->ws + WS_SUM);
    float* HIN = (float*)(pp->ws + WS_HIN);
    for (int gt = obid() * NTHR + otid(); gt < 2 * NB * 1024; gt += gridDim.x * NTHR) {
        const int dir = gt >> 13, rest = gt & 8191;
        const size_t base = (size_t)(dir * NB + (rest >> 10)) * NSLOT * 1024 + (rest & 1023);
        float h = 0.f;
#pragma unroll 1
        for (int j = 0; j < 3; ++j) {
            f32x2 ab[22];
#pragma unroll
            for (int ii = 0; ii < 22; ++ii) { const int i = 22 * j + ii; const int s = dir == 0 ? i : (i == 0 ? 1 : (i == 1 ? 0 : NSLOT + 1 - i)); ab[ii] = SUM[base + (size_t)s * 1024]; }
#pragma unroll
            for (int ii = 0; ii < 22; ++ii) { const int i = 22 * j + ii; const int s = dir == 0 ? i : (i == 0 ? 1 : (i == 1 ? 0 : NSLOT + 1 - i)); HIN[base + (size_t)s * 1024] = h; h = ab[ii].x * h + ab[ii].y; }
        }
    }
}

__device__ __forceinline__ void sgu_spatial(CP pp, LAS unsigned char* lds) {
    LAS unsigned* VT = (LAS unsigned*)lds;
    LAS unsigned char* WST = lds + 67584;
    LAS float* MU = (LAS float*)(lds + 67584 + 34816);
    LAS float* RS = MU + 128;
    LAS float* M1 = MU + 256;
    LAS float* M2 = MU + 384;
    const int tid = otid(), lane = tid & 63, wave = tid >> 6, fr = lane & 15, fq = lane >> 4;
    bf16_t* Zs = (bf16_t*)(pp->ws + WS_G);
    const f32x2* STAT = (const f32x2*)(pp->ws + WS_Y);
    const bf16_t* WsB = (const bf16_t*)(pp->ws + WS_WSB);
    const float* ln_g = pp->in[22]; const float* ln_b = pp->in[23]; const float* bs = pp->in[25];
    for (int cidx = obid(); cidx < 512; cidx += gridDim.x) {
        const int r0 = cidx * 128;
#pragma unroll
        for (int it = 0; it < 4; ++it) {
            const int id = it * NTHR + tid, pp_ = id >> 4;
            const f32x4 t = *(const f32x4*)((const float*)(STAT + (size_t)r0 * 32) + (size_t)id * 4);
            float sm = t[0] + t[2], sq = t[1] + t[3];
#pragma unroll
            for (int o = 1; o < 16; o <<= 1) { sm += __shfl_xor(sm, o); sq += __shfl_xor(sq, o); }
            if ((id & 15) == 0) { const float mean = sm * (1.0f / DSGU), var = sq * (1.0f / DSGU) - mean * mean; MU[pp_] = mean; RS[pp_] = 1.0f / sqrtf(fmaxf(var, 0.f) + EPS); }
        }
        __syncthreads();
#pragma unroll 1
        for (int g = 0; g < 8; ++g) {
            {
                const int cb = tid & 31;
                u32x4 raw[8];
#pragma unroll
                for (int it = 0; it < 8; ++it) raw[it] = __builtin_nontemporal_load((const u32x4*)(Zs + (size_t)(r0 + it * 16 + (tid >> 5)) * 4096 + 2048 + 256 * g + 8 * cb));
#pragma unroll
                for (int it = 0; it < 8; ++it) *(LAS u32x4*)(VT + (it * 16 + (tid >> 5)) * 132 + cb * 4) = raw[it];
            }
#pragma unroll
            for (int it = 0; it < 4; ++it) {
                const int id = it * NTHR + tid, q = id >> 4, pc = id & 15;
                const u32x4 rw = *(const u32x4*)(WsB + (size_t)(g * 128 + q) * 128 + pc * 8);
                const f32x4 rs0 = *(const LAS f32x4*)(RS + 8 * pc), rs1 = *(const LAS f32x4*)(RS + 8 * pc + 4), mu0 = *(const LAS f32x4*)(MU + 8 * pc), mu1 = *(const LAS f32x4*)(MU + 8 * pc + 4);
                const f32x4 w0 = {bf_lo(rw.x), bf_hi(rw.x), bf_lo(rw.y), bf_hi(rw.y)}, w1 = {bf_lo(rw.z), bf_hi(rw.z), bf_lo(rw.w), bf_hi(rw.w)};
                float m2p = (w0[0] + w0[1]) + (w0[2] + w0[3]) + (w1[0] + w1[1]) + (w1[2] + w1[3]);
                const f32x4 s0 = w0 * rs0, s1 = w1 * rs1;
                u32x4 wp; wp.x = pk2(s0[0], s0[1]); wp.y = pk2(s0[2], s0[3]); wp.z = pk2(s1[0], s1[1]); wp.w = pk2(s1[2], s1[3]);
                *(LAS u32x4*)(WST + q * 272 + pc * 16) = wp;
                float m1p = (bf_lo(wp.x) * mu0[0] + bf_hi(wp.x) * mu0[1]) + (bf_lo(wp.y) * mu0[2] + bf_hi(wp.y) * mu0[3]) + (bf_lo(wp.z) * mu1[0] + bf_hi(wp.z) * mu1[1]) + (bf_lo(wp.w) * mu1[2] + bf_hi(wp.w) * mu1[3]);
#pragma unroll
                for (int o = 1; o < 16; o <<= 1) { m1p += __shfl_xor(m1p, o); m2p += __shfl_xor(m2p, o); }
                if (pc == 0) { M1[q] = m1p; M2[q] = m2p; }
            }
            __syncthreads();
            {
                const int c0 = 32 * wave, cch = 256 * g + c0 + 8 * fq;
                u32x4 uu[8];
#pragma unroll
                for (int m = 0; m < 8; ++m) uu[m] = __builtin_nontemporal_load((const u32x4*)(Zs + (size_t)(r0 + 16 * m + fr) * 4096 + cch));
                float bsv[8];
#pragma unroll
                for (int m = 0; m < 8; ++m) bsv[m] = bs[g * 128 + 16 * m + fr];
                const f32x4 lg0 = *(const f32x4*)(ln_g + cch), lg1 = *(const f32x4*)(ln_g + cch + 4), lb0 = *(const f32x4*)(ln_b + cch), lb1 = *(const f32x4*)(ln_b + cch + 4);
                bf16x8 Vf[2][4];
#pragma unroll
                for (int n = 0; n < 2; ++n) {
                    const int col = c0 + 8 * (fr >> 2) + 4 * n + (fr & 3), word = col >> 1, sh = (col & 1) * 16;
#pragma unroll
                    for (int ks = 0; ks < 4; ++ks) {
                        unsigned e[8];
#pragma unroll
                        for (int i = 0; i < 8; ++i) e[i] = (VT[(32 * ks + 8 * fq + i) * 132 + word] >> sh) & 0xffffu;
                        u32x4 w; w.x = e[0] | (e[1] << 16); w.y = e[2] | (e[3] << 16); w.z = e[4] | (e[5] << 16); w.w = e[6] | (e[7] << 16);
                        Vf[n][ks] = __builtin_bit_cast(bf16x8, w);
                        asm volatile("" ::: "memory");
                    }
                }
#pragma unroll
                for (int m = 0; m < 8; ++m) {
                    f32x4 acc[2] = {{0.f, 0.f, 0.f, 0.f}, {0.f, 0.f, 0.f, 0.f}};
#pragma unroll
                    for (int ks = 0; ks < 4; ++ks) {
                        const bf16x8 Wf = *(const LAS bf16x8*)(WST + (16 * m + fr) * 272 + (32 * ks + 8 * fq) * 2);
                        acc[0] = __builtin_amdgcn_mfma_f32_16x16x32_bf16(Vf[0][ks], Wf, acc[0], 0, 0, 0);
                        acc[1] = __builtin_amdgcn_mfma_f32_16x16x32_bf16(Vf[1][ks], Wf, acc[1], 0, 0, 0);
                    }
                    const int q = 16 * m + fr; const float m1 = M1[q], m2 = M2[q], bsq = bsv[m];
                    const f32x4 s0 = lg0 * (acc[0] - m1) + (lb0 * m2 + bsq), s1 = lg1 * (acc[1] - m1) + (lb1 * m2 + bsq);
                    u32x4* up = (u32x4*)(Zs + (size_t)(r0 + q) * 4096 + cch);
                    const u32x4 u_ = uu[m]; u32x4 w;
                    w.x = pk2(bf_lo(u_.x) * s0[0], bf_hi(u_.x) * s0[1]); w.y = pk2(bf_lo(u_.y) * s0[2], bf_hi(u_.y) * s0[3]);
                    w.z = pk2(bf_lo(u_.z) * s1[0], bf_hi(u_.z) * s1[1]); w.w = pk2(bf_lo(u_.w) * s1[2], bf_hi(u_.w) * s1[3]);
                    *up = w;
                    asm volatile("" ::: "memory");
                }
            }
            __syncthreads();
        }
    }
}

#define FB_LD(p) __hip_atomic_load((p), __ATOMIC_RELAXED, __HIP_MEMORY_SCOPE_AGENT)
#define FB_ST(p, v) __hip_atomic_store((p), (v), __ATOMIC_RELAXED, __HIP_MEMORY_SCOPE_AGENT)
__device__ __forceinline__ void flag_barrier(unsigned* base, unsigned gen) {
    asm volatile("s_waitcnt vmcnt(0)" ::: "memory");
    __syncthreads();
    if (threadIdx.x < 64) {
        const int c = blockIdx.x, G = gridDim.x, lane = threadIdx.x;
        __builtin_amdgcn_fence(__ATOMIC_RELEASE, "agent");
        asm volatile("s_waitcnt vmcnt(0)" ::: "memory");
        if (lane == 0) FB_ST(base + 64 * (1 + c), gen);
        if (c == 0) {
            unsigned sp = 0;
            for (;;) {
                unsigned ok = 1u;
                for (int m = lane; m < G; m += 64) ok &= (unsigned)(FB_LD(base + 64 * (1 + m)) >= gen);
                if (__all((int)ok)) break;
                __builtin_amdgcn_s_sleep(1); if (++sp > (1u << 22)) break;
            }
            if (lane == 0) FB_ST(base, gen);
        }
        { unsigned sp = 0; while (FB_LD(base) < gen) { __builtin_amdgcn_s_sleep(1); if (++sp > (1u << 22)) break; } }
        __builtin_amdgcn_fence(__ATOMIC_ACQUIRE, "agent");
        asm volatile("s_waitcnt vmcnt(0)" ::: "memory");
    }
    __syncthreads();
}

__device__ __forceinline__ void run_phase(CP pp, int ph, LAS unsigned char* lds) {
    unsigned char* ws = pp->ws;
    bf16_t* H = (bf16_t*)(ws + WS_H); bf16_t* G = (bf16_t*)(ws + WS_G); bf16_t* Y = (bf16_t*)(ws + WS_Y);
    int ffn = -1, sub = 0;
    if (ph >= 2 && ph <= 4) { ffn = 0; sub = ph - 2; } else if (ph >= 11 && ph <= 13) { ffn = 1; sub = ph - 11; }
    else if (ph >= 14 && ph <= 16) { ffn = 2; sub = ph - 14; } else if (ph >= 21 && ph <= 23) { ffn = 3; sub = ph - 21; }
    if ((PHM & 1) && ph == 0) { phase_prep(pp, lds); return; }
    if ((PHM & 2) && ph == 1) { phase_rows(pp, 0, MT, 0, 0, 0.f, 1, 0, 0); return; }
    if ((PHM & 4) && ffn >= 0 && sub == 0) {
        const int M = ffn == 0 ? MT : NLAT;
        pg8::Gemm g{H, (const bf16_t*)(ws + WS_WUP) + (size_t)ffn * NUP * 1024, M, NUP, 1024, 1024}; pg8::StaticOrder S; S.init(M, NUP, gridDim.x, obid());
        EpiSwiglu E{G, DFF};
        pg8::gemm_phase<EpiSwiglu, pg8::StaticOrder, true, true>(lds, g, S, E);
        return;
    }
    if ((PHM & 8) && ((ffn >= 0 && sub == 1) || ph == 9 || ph == 19)) {
        int M = NLAT, K = DFF, lda = DFF; const bf16_t* Bt;
        if (ffn >= 0) { M = ffn == 0 ? MT : NLAT; Bt = (const bf16_t*)(ws + WS_WDN) + (size_t)ffn * 1024 * DFF; }
        else if (ph == 9) { K = 1024; lda = 2048; Bt = (const bf16_t*)(ws + WS_LOUT); }
        else { K = 2048; lda = 4096; Bt = (const bf16_t*)(ws + WS_SOUT); }
        pg8::Gemm g{G, Bt, M, 1024, K, lda}; pg8::StaticOrder S; S.init(M, 1024, gridDim.x, obid());
        EpiAct E{Y, 1024, nullptr, 0, 1 << 20, nullptr};
        pg8::gemm_phase<EpiAct, pg8::StaticOrder, true, true>(lds, g, S, E);
        return;
    }
    if ((PHM & 2) && ((ffn >= 0 && sub == 2) || ph == 10 || ph == 20)) {
        int li, k, rows = NLAT, has_pre = 1, li2, k2; float wgt = 0.5f;
        if (ph == 4) { li = 0; k = 0; li2 = 0; k2 = 1; rows = MT; }
        else if (ph == 10) { li = 0; k = 1; li2 = 0; k2 = 2; wgt = 1.0f; }
        else if (ph == 13) { li = 0; k = 2; li2 = 1; k2 = 0; }
        else if (ph == 16) { li = 1; k = 0; li2 = 1; k2 = 1; }
        else if (ph == 20) { li = 1; k = 1; li2 = 1; k2 = 2; wgt = 1.0f; }
        else { li = 1; k = 2; li2 = 1; k2 = 2; has_pre = 0; }
        phase_rows(pp, 1, rows, li, k, wgt, has_pre, li2, k2);
        return;
    }
    if ((PHM & 16) && (ph == 5 || ph == 17)) {
        int M, N; const bf16_t* Bt; EpiAct E;
        if (ph == 5) { M = MT; N = 2048; Bt = (const bf16_t*)(ws + WS_LIN); E = EpiAct{G, 2048, nullptr, 4, 1 << 20, nullptr}; }
        else { M = NLAT; N = 4096; Bt = (const bf16_t*)(ws + WS_SIN); E = EpiAct{G, 4096, pp->in[21], 16, 8, (f32x2*)(ws + WS_Y)}; }
        pg8::Gemm g{H, Bt, M, N, 1024, 1024}; pg8::StaticOrder S; S.init(M, N, gridDim.x, obid());
        pg8::gemm_phase<EpiAct, pg8::StaticOrder, true, true>(lds, g, S, E);
        return;
    }
    if ((PHM & 32) && ph == 6) { lru_pass<1>(pp, lds); return; }
    if ((PHM & 64) && ph == 7) { lru_carry(pp); return; }
    if ((PHM & 128) && ph == 8) { lru_pass<2>(pp, lds); return; }
    if ((PHM & 256) && ph == 18) { sgu_spatial(pp, lds); return; }
}

__device__ __forceinline__ CP get_params() {
    CP k = (CP)__builtin_amdgcn_kernarg_segment_ptr();
    asm volatile("" : "+s"(k));
    return k;
}
__global__ void __launch_bounds__(NTHR, 2) trunk_fwd(Params p) {
    extern __shared__ __attribute__((aligned(16))) unsigned char lds_raw[];
    LAS unsigned char* lds = (LAS unsigned char*)lds_raw;
    const int lo = p.ph_lo, hi = p.ph_hi;
#if ONE_LAUNCH
    if (blockIdx.x == 0) { unsigned* cw = (unsigned*)(p.ws + WS_CTL); for (int i = threadIdx.x; i < 64 * ((int)gridDim.x + 1); i += NTHR) cw[i] = 0u; }
#endif
    unsigned bgen = 0u;
    for (int ph = lo; ph < hi; ++ph) {
        run_phase(get_params(), ph, lds);
#if ONE_LAUNCH
        if (ph + 1 < hi) {
            if (ph == lo) { __syncthreads(); cg::this_grid().sync(); }
            else { flag_barrier((unsigned*)(get_params()->ws + WS_CTL), ++bgen);
#ifdef PROBE_DOUBLE
                   flag_barrier((unsigned*)(get_params()->ws + WS_CTL), ++bgen);
#endif
            }
        }
#endif
    }
}

extern "C" void kernel_launch(void* const* d_in, const int* in_sizes, int n_in, void* d_out, int out_size, void* d_ws, size_t ws_size, hipStream_t stream) {
    static int grid = 0;
    if (grid == 0) {
        if (n_in != 27 || ws_size < WS_END) { fprintf(stderr, "kernel_launch: unexpected n_in %d / ws_size %zu\n", n_in, ws_size); grid = -1; return; }
        if (hipFuncSetAttribute((const void*)trunk_fwd, hipFuncAttributeMaxDynamicSharedMemorySize, LDS_BYTES) != hipSuccess) { fprintf(stderr, "hipFuncSetAttribute failed\n"); grid = -1; return; }
        int dev = 0, cus = 0, per_cu = 0;
        hipGetDevice(&dev); hipDeviceGetAttribute(&cus, hipDeviceAttributeMultiprocessorCount, dev);
        hipOccupancyMaxActiveBlocksPerMultiprocessor(&per_cu, (const void*)trunk_fwd, NTHR, LDS_BYTES);
        (void)hipGetLastError();
        if (per_cu < 1) fprintf(stderr, "kernel_launch: occupancy query says %d blocks per CU\n", per_cu);
        grid = cus > 0 ? cus : 256;
    }
    if (grid < 0) return;
    Params p{};
    for (int i = 0; i < 27; ++i) p.in[i] = (const float*)d_in[i];
    p.out = (float*)d_out; p.ws = (unsigned char*)d_ws;
#if ONE_LAUNCH
    p.ph_lo = 0; p.ph_hi = NPHASE;
    void* args[] = {&p};
    hipError_t e = hipLaunchCooperativeKernel((const void*)trunk_fwd, dim3(grid), dim3(NTHR), args, LDS_BYTES, stream);
    if (e != hipSuccess) fprintf(stderr, "cooperative launch failed: %s (grid %d)\n", hipGetErrorString(e), grid);
#else
    for (int ph = 0; ph < NPHASE; ++ph) {
        p.ph_lo = ph; p.ph_hi = ph + 1;
        hipLaunchKernelGGL(trunk_fwd, dim3(grid), dim3(NTHR), LDS_BYTES, stream, p);
    }
#endif
}
```

```cpp
#include <hip/hip_runtime.h>
#include <hip/hip_cooperative_groups.h>
#include <cstdio>
#include <cstdint>
namespace cg = cooperative_groups;
#ifndef ONE_LAUNCH
#define ONE_LAUNCH 1
#endif
#ifndef PHM
#define PHM 0xffff
#endif
__device__ __forceinline__ int otid() { int t = threadIdx.x; asm volatile("" : "+v"(t)); return t; }
__device__ __forceinline__ int obid() { int b = blockIdx.x; asm volatile("" : "+s"(b)); return b; }
namespace pg8 {
#define PG8_LAS __attribute__((address_space(3)))
typedef unsigned short bf16_t;
typedef short bf16x8 __attribute__((ext_vector_type(8)));
typedef float f32x4 __attribute__((ext_vector_type(4)));
typedef unsigned u32x4 __attribute__((ext_vector_type(4)));
constexpr int BM = 256, BK = 64, HALF = 128, HTB = HALF * BK * 2  , STAGE_BYTES = 8 * HTB, NXCD = 8, WGM = 8;

__host__ __device__ __forceinline__ int lds_byte(int r, int c) { const int st = (r >> 4) * 2 + (c >> 5), rr = r & 15, cc = c & 31, ob = rr * 64 + cc * 2; return st * 1024 + (ob ^ (((ob >> 9) & 1) << 5)); }
__host__ __device__ __forceinline__ void stage_rc(int b, int& R, int& C) { const int st = b / 1024, sb = b % 1024, swz = sb ^ (((sb >> 9) & 1) << 5); R = (st >> 1) * 16 + swz / 64; C = (st & 1) * 32 + (swz % 64) / 2; }
__host__ __device__ __forceinline__ int perm32(int rho) { const int n = rho >> 4, i = rho & 15; return 8 * (i >> 2) + 4 * n + (i & 3); }

struct Unit { int pm, pn; };
struct Gemm { const bf16_t* A; const bf16_t* Bt; int M, N, K, lda; };

struct StaticOrder {
    int nM, nN, nwg, G, c;
    __host__ __device__ void init(int M, int N, int G_, int c_) { nM = M / BM; nN = N / BM; nwg = nM * nN; G = G_; c = c_; }
    __host__ __device__ bool next(int i, Unit& u) const {
        const long L = (long)i * G + c; if (L >= nwg) return false;
        int wgid = (int)L; { const int q = nwg / NXCD, r = nwg % NXCD, xcd = wgid % NXCD, off = wgid / NXCD; wgid = (xcd < r ? xcd * (q + 1) : r * (q + 1) + (xcd - r) * q) + off; }
        const int nig = WGM * nN, gid = wgid / nig, fm = gid * WGM, gsz = (nM - fm) < WGM ? (nM - fm) : WGM;
        u.pm = fm + ((wgid % nig) % gsz); u.pn = (wgid % nig) / gsz; return true;
    }
    __device__ __forceinline__ void a_ready(const Unit&) const {}
    __device__ __forceinline__ void done(const Unit&) const {}
};
__device__ __forceinline__ unsigned cvt_pk_bf16(float lo, float hi) { unsigned r; asm volatile("v_cvt_pk_bf16_f32 %0, %1, %2" : "=v"(r) : "v"(lo), "v"(hi)); return r; }
typedef float f32x2 __attribute__((ext_vector_type(2)));
template <class Epi, class Sched, bool ALIGN_EPI = false, bool SP2 = false>
__device__ __forceinline__ void gemm_phase(PG8_LAS unsigned char* lds, const Gemm g, const Sched& S, const Epi& E) {
    const int tid = otid(), wid = __builtin_amdgcn_readfirstlane(tid >> 6), lane = tid & 63, wr = wid >> 2, wc = wid & 3, fr = lane & 15, fq = lane >> 4;
    const int K = g.K, nt = K / BK;
    unsigned voffA[2], voffB[2];
#pragma unroll
    for (int i = 0; i < 2; ++i) { int R, C; stage_rc(tid * 16 + i * 8192, R, C); const int Rb = Epi::PERM ? ((R & ~31) + perm32(R & 31)) : R;
        voffA[i] = (unsigned)(R * g.lda + C) * 2u; voffB[i] = (unsigned)(Rb * K + C) * 2u; }
    const size_t kstep = (size_t)(BK * 2);
    const size_t hstepB = (size_t)HALF * K * 2, hstepA = (size_t)HALF * g.lda * 2;
    const size_t tstepA = 2 * hstepA, tstepB = 2 * hstepB;
    const unsigned ldsw = (unsigned)wid * 1024u;
    const int aoff = lds_byte(wr * 64 + fr, fq * 8), boff = lds_byte(wc * 32 + fr, fq * 8);
#define PG8_SA(b, h) (((b) * 2 + (h)) * HTB)
#define PG8_SB(b, h) ((4 + (b) * 2 + (h)) * HTB)
#define PG8_STAGE(bufoff, gbase, voff) do { _Pragma("unroll") for (int _i = 0; _i < 2; ++_i) \
        __builtin_amdgcn_global_load_lds((const unsigned*)((const char*)(gbase) + (voff)[_i]), (PG8_LAS unsigned*)(lds + (bufoff) + ldsw + _i * 8192), 16, 0, 0); } while (0)
#define PG8_LDA(dst, b, h) do { _Pragma("unroll") for (int m = 0; m < 4; ++m) _Pragma("unroll") for (int k = 0; k < 2; ++k) dst[m][k] = *(const PG8_LAS bf16x8*)(lds + PG8_SA(b, h) + aoff + m * 2048 + k * 1024); } while (0)
#define PG8_LDB(dst, b, h) do { _Pragma("unroll") for (int n = 0; n < 2; ++n) _Pragma("unroll") for (int k = 0; k < 2; ++k) dst[n][k] = *(const PG8_LAS bf16x8*)(lds + PG8_SB(b, h) + boff + n * 2048 + k * 1024); } while (0)
#define PG8_MMA(ai, bj, At, Bt) do { __builtin_amdgcn_s_setprio(1); _Pragma("unroll") for (int m = 0; m < 4; ++m) _Pragma("unroll") for (int n = 0; n < 2; ++n) _Pragma("unroll") for (int k = 0; k < 2; ++k) \
        acc[ai][bj][m][n] = __builtin_amdgcn_mfma_f32_16x16x32_bf16(Bt[n][k], At[m][k], acc[ai][bj][m][n], 0, 0, 0); __builtin_amdgcn_s_setprio(0); } while (0)
#define PG8_WAIT_V(n) asm volatile("s_waitcnt vmcnt(" #n ")" ::: "memory")
#define PG8_WAIT_L(n) asm volatile("s_waitcnt lgkmcnt(" #n ")" ::: "memory")
#define PG8_BAR __builtin_amdgcn_s_barrier()
#define PG8_SCHED __builtin_amdgcn_sched_barrier(0)
    Unit cur, nxt; int ui = 0;
    if (!S.next(0, cur)) return;
    f32x4 acc[2][2][4][2];
#pragma unroll
    for (int a = 0; a < 2; ++a)
#pragma unroll
        for (int b = 0; b < 2; ++b)
#pragma unroll
            for (int m = 0; m < 4; ++m)
#pragma unroll
                for (int n = 0; n < 2; ++n) acc[a][b][m][n] = (f32x4){0.f, 0.f, 0.f, 0.f};
    bf16x8 At[4][2], B0[2][2], B1[2][2];
    const char* cA = (const char*)g.A + (size_t)cur.pm * tstepA; const char* cB = (const char*)g.Bt + (size_t)cur.pn * tstepB;
    S.a_ready(cur);
    if constexpr (SP2) {
        PG8_STAGE(PG8_SB(0, 0), cB, voffB); PG8_STAGE(PG8_SB(0, 1), cB + hstepB, voffB); PG8_STAGE(PG8_SA(0, 0), cA, voffA); PG8_STAGE(PG8_SA(0, 1), cA + hstepA, voffA);
        if (wr == 1) PG8_BAR;
        PG8_WAIT_V(2); PG8_BAR;
        PG8_STAGE(PG8_SB(1, 0), cB + kstep, voffB); PG8_STAGE(PG8_SA(1, 0), cA + kstep, voffA); PG8_STAGE(PG8_SB(1, 1), cB + hstepB + kstep, voffB);
        PG8_WAIT_V(6); PG8_BAR;
    } else {
        PG8_STAGE(PG8_SB(0, 0), cB, voffB); PG8_STAGE(PG8_SA(0, 0), cA, voffA); PG8_STAGE(PG8_SB(0, 1), cB + hstepB, voffB); PG8_STAGE(PG8_SA(0, 1), cA + hstepA, voffA);
        if (wr == 1) PG8_BAR;
        PG8_WAIT_V(4); PG8_BAR;
        PG8_STAGE(PG8_SB(1, 0), cB + kstep, voffB); PG8_STAGE(PG8_SA(1, 0), cA + kstep, voffA); PG8_STAGE(PG8_SB(1, 1), cB + hstepB + kstep, voffB);
        PG8_WAIT_V(6); PG8_BAR;
    }
    for (;;) {
        const bool has_next = S.next(ui + 1, nxt);
        const char* nA = has_next ? (const char*)g.A + (size_t)nxt.pm * tstepA : cA; const char* nB = has_next ? (const char*)g.Bt + (size_t)nxt.pn * tstepB : cB;
        for (int t = 0; t < nt; t += 2) {
            const bool last = (t == nt - 2);
            const char* a1 = cA + (size_t)(t + 1) * kstep;
            const char* a2 = last ? nA : cA + (size_t)(t + 2) * kstep; const char* b2 = last ? nB : cB + (size_t)(t + 2) * kstep;
            const char* a3 = a2 + kstep; const char* b3 = b2 + kstep;
            if (last && has_next) S.a_ready(nxt);
            if constexpr (SP2) {
            PG8_LDB(B0, 0, 0); PG8_LDB(B1, 0, 1); PG8_SCHED; PG8_LDA(At, 0, 0); PG8_STAGE(PG8_SA(1, 1), a1 + hstepA, voffA);
            PG8_WAIT_V(8); PG8_WAIT_L(0); PG8_BAR; PG8_MMA(0, 0, At, B0); PG8_MMA(0, 1, At, B1); PG8_BAR; PG8_SCHED;
            PG8_LDA(At, 0, 1); PG8_STAGE(PG8_SB(0, 0), b2, voffB); PG8_STAGE(PG8_SB(0, 1), b2 + hstepB, voffB); PG8_STAGE(PG8_SA(0, 0), a2, voffA);
            PG8_WAIT_V(8); PG8_WAIT_L(0); PG8_BAR; PG8_MMA(1, 0, At, B0); PG8_MMA(1, 1, At, B1); PG8_BAR; PG8_SCHED;
            PG8_LDB(B0, 1, 0); PG8_LDB(B1, 1, 1); PG8_SCHED; PG8_LDA(At, 1, 0); PG8_STAGE(PG8_SA(0, 1), a2 + hstepA, voffA);
            PG8_WAIT_V(8); PG8_WAIT_L(0); PG8_BAR; PG8_MMA(0, 0, At, B0); PG8_MMA(0, 1, At, B1); PG8_BAR; PG8_SCHED;
            PG8_LDA(At, 1, 1); PG8_STAGE(PG8_SB(1, 0), b3, voffB); PG8_STAGE(PG8_SB(1, 1), b3 + hstepB, voffB); PG8_STAGE(PG8_SA(1, 0), a3, voffA);
            PG8_WAIT_V(8); PG8_WAIT_L(0); PG8_BAR; PG8_MMA(1, 0, At, B0); PG8_MMA(1, 1, At, B1); PG8_BAR; PG8_SCHED;
            } else {
            PG8_LDB(B0, 0, 0); PG8_SCHED; PG8_LDA(At, 0, 0); PG8_STAGE(PG8_SA(1, 1), a1 + hstepA, voffA);
            PG8_WAIT_L(8); PG8_BAR; PG8_WAIT_L(0); PG8_MMA(0, 0, At, B0); PG8_BAR; PG8_SCHED;
            PG8_LDB(B1, 0, 1); PG8_STAGE(PG8_SB(0, 0), b2, voffB);
            PG8_BAR; PG8_WAIT_L(0); PG8_MMA(0, 1, At, B1); PG8_BAR;
            PG8_LDA(At, 0, 1); PG8_STAGE(PG8_SA(0, 0), a2, voffA);
            PG8_BAR; PG8_WAIT_L(0); PG8_MMA(1, 0, At, B0); PG8_BAR; PG8_SCHED;
            PG8_STAGE(PG8_SB(0, 1), b2 + hstepB, voffB);
            PG8_WAIT_V(6); PG8_BAR; PG8_MMA(1, 1, At, B1); PG8_BAR;
            PG8_LDB(B0, 1, 0); PG8_SCHED; PG8_LDA(At, 1, 0); PG8_STAGE(PG8_SA(0, 1), a2 + hstepA, voffA);
            PG8_WAIT_L(8); PG8_BAR; PG8_WAIT_L(0); PG8_MMA(0, 0, At, B0); PG8_BAR; PG8_SCHED;
            PG8_LDB(B1, 1, 1); PG8_STAGE(PG8_SB(1, 0), b3, voffB);
            PG8_BAR; PG8_WAIT_L(0); PG8_MMA(0, 1, At, B1); PG8_BAR;
            PG8_LDA(At, 1, 1); PG8_STAGE(PG8_SA(1, 0), a3, voffA);
            PG8_BAR; PG8_WAIT_L(0); PG8_MMA(1, 0, At, B0); PG8_BAR; PG8_SCHED;
            PG8_STAGE(PG8_SB(1, 1), b3 + hstepB, voffB);
            PG8_WAIT_V(6); PG8_BAR; PG8_MMA(1, 1, At, B1); PG8_BAR;
            }
        }
        if constexpr (ALIGN_EPI) { if (wr == 0) PG8_BAR; }
        if constexpr (!Epi::AFTER_DRAIN) { E(acc, cur, wr, wc, fr, fq); S.done(cur); }
        if (!has_next) break;
#pragma unroll
        for (int a = 0; a < 2; ++a)
#pragma unroll
            for (int b = 0; b < 2; ++b)
#pragma unroll
                for (int m = 0; m < 4; ++m)
#pragma unroll
                    for (int n = 0; n < 2; ++n) acc[a][b][m][n] = (f32x4){0.f, 0.f, 0.f, 0.f};
        cur = nxt; cA = nA; cB = nB; ++ui;
        if constexpr (ALIGN_EPI) { if (wr == 1) PG8_BAR; }
    }
    PG8_WAIT_V(0);
    if constexpr (!ALIGN_EPI) { if (wr == 0) PG8_BAR; }
    PG8_BAR;
    if constexpr (Epi::AFTER_DRAIN) { E.fused(acc, cur, wr, wc, fr, fq, lds, wid, lane); S.done(cur); }
#undef PG8_SA
#undef PG8_SB
#undef PG8_STAGE
#undef PG8_LDA
#undef PG8_LDB
#undef PG8_MMA
#undef PG8_WAIT_V
#undef PG8_WAIT_L
#undef PG8_BAR
#undef PG8_SCHED
}
}

#define LAS __attribute__((address_space(3)))
typedef unsigned short bf16_t;
typedef short bf16x8 __attribute__((ext_vector_type(8)));
typedef float f32x4 __attribute__((ext_vector_type(4)));
typedef float f32x2 __attribute__((ext_vector_type(2)));
typedef unsigned u32x4 __attribute__((ext_vector_type(4)));
typedef unsigned u32x2 __attribute__((ext_vector_type(2)));

constexpr int D = 1024, NB = 8, SEQ = 8192, NLAT = NB * SEQ, CTXL = 256, NCTX = NB * CTXL, MT = NLAT + NCTX;
constexpr int DFF = 2816, NUP = 2 * DFF, DSGU = 2048, NSLOT = 66;
constexpr float EPS = 1e-6f;
constexpr int NTHR = 512, NWAVES = 8;
constexpr int LDS_BYTES = 147456;
constexpr int NPHASE = 24;

constexpr size_t MiB = 1u << 20;
constexpr size_t WS_X16 = 360 * MiB;
constexpr size_t WS_CTL = 0, WS_MOD = 1 * MiB, WS_XC = 2 * MiB, WS_WG = 10 * MiB, WS_WSB = 11 * MiB, WS_WUP = 12 * MiB, WS_WDN = 56 * MiB, WS_LIN = 78 * MiB,
                 WS_LOUT = 82 * MiB, WS_SIN = 84 * MiB, WS_SOUT = 92 * MiB, WS_H = 96 * MiB, WS_Y = 228 * MiB, WS_G = 492 * MiB, WS_SUM = 1004 * MiB,
                 WS_HIN = 1013 * MiB, WS_END = 1018 * MiB;

struct Params;
typedef const __attribute__((address_space(4))) Params* CP;
struct Params {
    const float* in[27];
    float* out;
    unsigned char* ws;
    int ph_lo, ph_hi;
};

__device__ __forceinline__ unsigned f2bf(float f) { unsigned u = __builtin_bit_cast(unsigned, f); return (u + 0x7fffu + ((u >> 16) & 1u)) >> 16; }
__device__ __forceinline__ unsigned pk2(float lo, float hi) { return pg8::cvt_pk_bf16(lo, hi); }
__device__ __forceinline__ float bf_lo(unsigned w) { return __builtin_bit_cast(float, w << 16); }
__device__ __forceinline__ float bf_hi(unsigned w) { return __builtin_bit_cast(float, w & 0xffff0000u); }
typedef _Float16 h16x2 __attribute__((ext_vector_type(2)));
__device__ __forceinline__ unsigned pk2h(float lo, float hi) { h16x2 v; v.x = (_Float16)lo; v.y = (_Float16)hi; return __builtin_bit_cast(unsigned, v); }
__device__ __forceinline__ float h_lo(unsigned w) { return (float)__builtin_bit_cast(h16x2, w).x; }
__device__ __forceinline__ float h_hi(unsigned w) { return (float)__builtin_bit_cast(h16x2, w).y; }
__device__ __forceinline__ float fast_exp(float x) { return __builtin_amdgcn_exp2f(x * 1.4426950408889634f); }
__device__ __forceinline__ float sigmoidf_(float x) { return __builtin_amdgcn_rcpf(1.0f + fast_exp(-x)); }
__device__ __forceinline__ float siluf_(float x) { return x * sigmoidf_(x); }
__device__ __forceinline__ float gelu_tanh(float x) { const float u = 1.5957691216057308f * (x + 0.044715f * x * x * x); return x * sigmoidf_(u); }
__device__ __forceinline__ float wave_sum(float v) {
#pragma unroll
    for (int o = 1; o < 64; o <<= 1) v += __shfl_xor(v, o);
    return v;
}

struct EpiSwiglu {
    static constexpr bool PERM = true, AFTER_DRAIN = false;
    bf16_t* O; int ldc;
    __device__ __forceinline__ void operator()(const f32x4 (&acc)[2][2][4][2], const pg8::Unit& u, int wr, int wc, int fr, int fq) const {
        const int row0 = u.pm * 256 + wr * 64 + fr, col0 = u.pn * 128 + wc * 32 + 8 * fq;
#pragma unroll
        for (int ai = 0; ai < 2; ++ai)
#pragma unroll
            for (int m = 0; m < 4; ++m) {
                bf16_t* rowp = O + (size_t)(row0 + ai * 128 + m * 16) * ldc + col0;
                const f32x4 a0 = acc[ai][0][m][0], a1 = acc[ai][0][m][1], g0 = acc[ai][1][m][0], g1 = acc[ai][1][m][1];
                u32x4 w;
                w.x = pk2(siluf_(a0[0]) * g0[0], siluf_(a0[1]) * g0[1]); w.y = pk2(siluf_(a0[2]) * g0[2], siluf_(a0[3]) * g0[3]);
                w.z = pk2(siluf_(a1[0]) * g1[0], siluf_(a1[1]) * g1[1]); w.w = pk2(siluf_(a1[2]) * g1[2], siluf_(a1[3]) * g1[3]);
                *(u32x4*)rowp = w;
            }
    }
};
struct EpiF32 {
    static constexpr bool PERM = false, AFTER_DRAIN = false;
    float* C; int ldc;
    __device__ __forceinline__ void operator()(const f32x4 (&acc)[2][2][4][2], const pg8::Unit& u, int wr, int wc, int fr, int fq) const {
        const int row0 = u.pm * 256 + wr * 64 + fr, col0 = u.pn * 256 + wc * 32 + 4 * fq;
#pragma unroll
        for (int ai = 0; ai < 2; ++ai)
#pragma unroll
            for (int m = 0; m < 4; ++m) { float* rowp = C + (size_t)(row0 + ai * 128 + m * 16) * ldc + col0;
#pragma unroll
                for (int bj = 0; bj < 2; ++bj)
#pragma unroll
                    for (int n = 0; n < 2; ++n) *(f32x4*)(rowp + bj * 128 + n * 16) = acc[ai][bj][m][n]; }
    }
};
struct EpiAct {
    static constexpr bool PERM = true, AFTER_DRAIN = false;
    bf16_t* O; int ldc; const float* bias; int gelu_tiles; int stat_tile0; f32x2* STAT;
    __device__ __forceinline__ void operator()(const f32x4 (&acc)[2][2][4][2], const pg8::Unit& u, int wr, int wc, int fr, int fq) const {
        const int row0 = u.pm * 256 + wr * 64 + fr, col0 = u.pn * 256 + wc * 32 + 8 * fq;
        const bool do_gelu = u.pn < gelu_tiles, do_stat = u.pn >= stat_tile0;
        f32x4 bv[2][2];
#pragma unroll
        for (int bj = 0; bj < 2; ++bj)
#pragma unroll
            for (int n = 0; n < 2; ++n) bv[bj][n] = bias ? *(const f32x4*)(bias + col0 + bj * 128 + 4 * n) : (f32x4){0.f, 0.f, 0.f, 0.f};
#pragma unroll
        for (int ai = 0; ai < 2; ++ai)
#pragma unroll
            for (int m = 0; m < 4; ++m) {
                const int row = row0 + ai * 128 + m * 16;
                bf16_t* rowp = O + (size_t)row * ldc + col0;
                float s = 0.f, ss = 0.f;
#pragma unroll
                for (int bj = 0; bj < 2; ++bj) {
                    f32x4 v0 = acc[ai][bj][m][0] + bv[bj][0], v1 = acc[ai][bj][m][1] + bv[bj][1];
                    if (do_gelu) {
#pragma unroll
                        for (int e = 0; e < 4; ++e) { v0[e] = gelu_tanh(v0[e]); v1[e] = gelu_tanh(v1[e]); }
                    }
#pragma unroll
                    for (int e = 0; e < 4; ++e) { s += v0[e] + v1[e]; ss += v0[e] * v0[e] + v1[e] * v1[e]; }
                    u32x4 w; w.x = pk2(v0[0], v0[1]); w.y = pk2(v0[2], v0[3]); w.z = pk2(v1[0], v1[1]); w.w = pk2(v1[2], v1[3]);
                    *(u32x4*)(rowp + bj * 128) = w;
                }
                if (do_stat) {
                    s += __shfl_xor(s, 16); s += __shfl_xor(s, 32); ss += __shfl_xor(ss, 16); ss += __shfl_xor(ss, 32);
                    if (fq == 0) STAT[(size_t)row * 32 + (u.pn - stat_tile0) * 4 + wc] = (f32x2){s, ss};
                }
            }
    }
};

__device__ __forceinline__ void transpose_tile64(const float* W, int K, int N, bf16_t* WT, int k0, int n0, int drow0, LAS float* scr, int lane, float scale = 1.0f) {
    const int lr = lane >> 4, lc = (lane & 15) * 4;
    f32x4 v[16];
#pragma unroll
    for (int i = 0; i < 16; ++i) v[i] = __builtin_nontemporal_load((const f32x4*)(W + (size_t)(k0 + 4 * i + lr) * N + n0 + lc));
#pragma unroll
    for (int i = 0; i < 16; ++i) { LAS float* d = scr + (4 * i + lr) * 65 + lc; d[0] = v[i][0] * scale; d[1] = v[i][1] * scale; d[2] = v[i][2] * scale; d[3] = v[i][3] * scale; }
    asm volatile("s_waitcnt lgkmcnt(0)" ::: "memory");
    const int c = lane & 7;
#pragma unroll
    for (int j = 0; j < 8; ++j) { const int n = (lane >> 3) + 8 * j; const LAS float* s = scr + (8 * c) * 65 + n;
        u32x4 o; o.x = pk2(s[0 * 65], s[1 * 65]); o.y = pk2(s[2 * 65], s[3 * 65]); o.z = pk2(s[4 * 65], s[5 * 65]); o.w = pk2(s[6 * 65], s[7 * 65]);
        *(u32x4*)(WT + (size_t)(drow0 + n) * K + k0 + 8 * c) = o; }
    asm volatile("s_waitcnt lgkmcnt(0)" ::: "memory");
}

__device__ __forceinline__ void phase_prep(CP pp, LAS unsigned char* lds) {
    const int tid = otid(), lane = tid & 63, wave = tid >> 6;
    unsigned char* ws = pp->ws;
    if ((int)obid() < 144) {
        LAS float* S = (LAS float*)lds;
        LAS float* RED = S + 9 * 1024;
        const float* c = pp->in[1]; const float* cctx = pp->in[3]; const float* ada_w = pp->in[4]; const float* ada_b = pp->in[5];
        float* MOD = (float*)(ws + WS_MOD);
        for (int idx = tid; idx < 9 * 1024; idx += NTHR) { const int r = idx >> 10, k = idx & 1023; const float v = r < 8 ? c[r * 1024 + k] : cctx[k]; S[idx] = siluf_(v); }
        __syncthreads();
        for (int item = obid(); item < 144; item += gridDim.x) {
            const int layer = item / 72, n0 = (item % 72) * 128;
            const int half = lane >> 5, l32 = lane & 31;
            const float* W = ada_w + (size_t)layer * 1024 * 9216 + (size_t)(wave * 128 + half) * 9216 + n0 + 4 * l32;
            f32x4 acc[9];
#pragma unroll
            for (int r = 0; r < 9; ++r) acc[r] = (f32x4){0.f, 0.f, 0.f, 0.f};
#pragma unroll 1
            for (int ib = 0; ib < 4; ++ib) {
                f32x4 wv[16];
#pragma unroll
                for (int i = 0; i < 16; ++i) wv[i] = __builtin_nontemporal_load((const f32x4*)(W + (size_t)(2 * (16 * ib + i)) * 9216));
#pragma unroll
                for (int i = 0; i < 16; ++i) { const int k = wave * 128 + 2 * (16 * ib + i) + half;
#pragma unroll
                    for (int r = 0; r < 9; ++r) acc[r] += wv[i] * S[r * 1024 + k]; }
            }
#pragma unroll
            for (int r = 0; r < 9; ++r)
#pragma unroll
                for (int e = 0; e < 4; ++e) acc[r][e] += __shfl_xor(acc[r][e], 32);
            if (half == 0) {
#pragma unroll
                for (int r = 0; r < 9; ++r) *(LAS f32x4*)(RED + (wave * 9 + r) * 128 + 4 * l32) = acc[r];
            }
            __syncthreads();
            for (int idx = tid; idx < 9 * 128; idx += NTHR) { const int r = idx >> 7, l = idx & 127; float s = 0.f;
#pragma unroll
                for (int w = 0; w < 8; ++w) s += RED[(w * 9 + r) * 128 + l];
                MOD[(size_t)(layer * 9 + r) * 9216 + n0 + l] = s + ada_b[layer * 9216 + n0 + l]; }
            __syncthreads();
        }
    }
    {
        LAS float* scr = (LAS float*)(lds + wave * 16640);
        const int gw = obid() * NWAVES + wave, NGW = gridDim.x * NWAVES;
        constexpr int I_FFN = 704, I_LIN = 512, I_LOUT = 256, I_SIN = 1024, I_SOUT = 512, I_G = 128;
        constexpr int NITEMS = 12 * I_FFN + I_LIN + I_LOUT + I_SIN + I_SOUT + I_G;
        for (int it = gw; it < NITEMS; it += NGW) {
            int r = it;
            if (r < 12 * I_FFN) {
                const int mat = r / I_FFN, sub = r % I_FFN, idx = mat / 3, kind = mat % 3;
                if (kind < 2) {
                    const float* W = pp->in[kind == 0 ? 8 : 9] + (size_t)idx * 1024 * DFF;
                    const int nblk = DFF / 64, kb = sub / nblk, nb = sub % nblk, n0 = nb * 64;
                    transpose_tile64(W, 1024, DFF, (bf16_t*)(ws + WS_WUP) + (size_t)idx * NUP * 1024, kb * 64, n0, (n0 >> 7) * 256 + kind * 128 + (n0 & 127), scr, lane);
                } else {
                    const float* W = pp->in[10] + (size_t)idx * DFF * 1024;
                    const int nblk = 1024 / 64, kb = sub / nblk, nb = sub % nblk;
                    transpose_tile64(W, DFF, 1024, (bf16_t*)(ws + WS_WDN) + (size_t)idx * 1024 * DFF, kb * 64, nb * 64, nb * 64, scr, lane);
                }
                continue;
            }
            r -= 12 * I_FFN;
            if (r < I_LIN) { const int nblk = 2048 / 64; transpose_tile64(pp->in[11], 1024, 2048, (bf16_t*)(ws + WS_LIN), (r / nblk) * 64, (r % nblk) * 64, (r % nblk) * 64, scr, lane); continue; }
            r -= I_LIN;
            if (r < I_LOUT) { const int nblk = 1024 / 64; transpose_tile64(pp->in[19], 1024, 1024, (bf16_t*)(ws + WS_LOUT), (r / nblk) * 64, (r % nblk) * 64, (r % nblk) * 64, scr, lane); continue; }
            r -= I_LOUT;
            if (r < I_SIN) { const int nblk = 4096 / 64; transpose_tile64(pp->in[20], 1024, 4096, (bf16_t*)(ws + WS_SIN), (r / nblk) * 64, (r % nblk) * 64, (r % nblk) * 64, scr, lane); continue; }
            r -= I_SIN;
            if (r < I_SOUT) { const int nblk = 1024 / 64; transpose_tile64(pp->in[26], 2048, 1024, (bf16_t*)(ws + WS_SOUT), (r / nblk) * 64, (r % nblk) * 64, (r % nblk) * 64, scr, lane); continue; }
            r -= I_SOUT;
            {
                const int mat = r >> 2, sub = r & 3, gate = mat >> 4, dir = (mat >> 3) & 1, head = mat & 7;
                const float* W = pp->in[gate == 0 ? 14 : 16] + (size_t)(dir * 8 + head) * 128 * 128;
                bf16_t* WT = (bf16_t*)(ws + WS_WG) + (size_t)((head * 4 + dir * 2 + gate) * 128) * 128;
                transpose_tile64(W, 128, 128, WT, (sub >> 1) * 64, (sub & 1) * 64, (sub & 1) * 64, scr, lane, -1.4426950408889634f);
            }
        }
        { const float* W = pp->in[24]; unsigned* O = (unsigned*)(ws + WS_WSB);
          for (int i = obid() * NTHR + tid; i < 8 * 128 * 128 / 2; i += gridDim.x * NTHR) O[i] = pk2(W[2 * i], W[2 * i + 1]); }
    }
}

__device__ __forceinline__ void rows_one(CP pp, int mode, int r, int has_pre, const f32x4 (&gg)[4], const f32x4 (&pa)[4], const f32x4 (&pb)[4], int lane) {
    u32x2* xrow = (u32x2*)((unsigned short*)(pp->ws + WS_X16) + (size_t)r * D) + lane;
    f32x4 v[4];
    if (mode == 0) {
        if (r < NLAT) {
            const f32x4* xr = (const f32x4*)(pp->in[0] + (size_t)r * D) + lane;
            const int t = r & (SEQ - 1); const float prow = (float)(t >> 6), pcol = (float)(t & 63);
#pragma unroll
            for (int j = 0; j < 4; ++j) v[j] = __builtin_nontemporal_load(xr + 64 * j);
#pragma unroll
            for (int e = 0; e < 4; ++e) {
                const float om = __builtin_amdgcn_exp2f(-(float)(4 * lane + e) * (13.287712379549449f / 256.0f));
                float ar = prow * om * 0.15915494309189535f, ac = pcol * om * 0.15915494309189535f;
                ar -= __builtin_rintf(ar); ac -= __builtin_rintf(ac);
                v[0][e] += __builtin_amdgcn_sinf(ar); v[1][e] += __builtin_amdgcn_cosf(ar);
                v[2][e] += __builtin_amdgcn_sinf(ac); v[3][e] += __builtin_amdgcn_cosf(ac);
            }
        } else {
            const f32x4* xr = (const f32x4*)(pp->in[2] + (size_t)(r - NLAT) * D) + lane;
#pragma unroll
            for (int j = 0; j < 4; ++j) v[j] = __builtin_nontemporal_load(xr + 64 * j);
        }
    } else {
        const u32x2* yr = (const u32x2*)((const bf16_t*)(pp->ws + WS_Y) + (size_t)r * D) + lane;
        f32x4 y[4]; float ss = 0.f;
#pragma unroll
        for (int j = 0; j < 4; ++j) { const u32x2 w = __builtin_nontemporal_load(yr + 64 * j); const u32x2 xw_ = __builtin_nontemporal_load(xrow + 64 * j); v[j] = (f32x4){h_lo(xw_.x), h_hi(xw_.x), h_lo(xw_.y), h_hi(xw_.y)}; y[j] = (f32x4){bf_lo(w.x), bf_hi(w.x), bf_lo(w.y), bf_hi(w.y)}; ss += (y[j][0] * y[j][0] + y[j][1] * y[j][1]) + (y[j][2] * y[j][2] + y[j][3] * y[j][3]); }
        const float rstd = 1.0f / sqrtf(wave_sum(ss) * (1.0f / D) + EPS);
#pragma unroll
        for (int j = 0; j < 4; ++j) v[j] = v[j] + gg[j] * (y[j] * rstd);
    }
    if (has_pre) {
#pragma unroll
        for (int j = 0; j < 4; ++j) { u32x2 w; w.x = pk2h(v[j][0], v[j][1]); w.y = pk2h(v[j][2], v[j][3]); __builtin_nontemporal_store(w, xrow + 64 * j); }
    } else {
        f32x4* xw = (f32x4*)(pp->out + (size_t)r * D) + lane;
#pragma unroll
        for (int j = 0; j < 4; ++j) __builtin_nontemporal_store(v[j], xw + 64 * j);
    }
    if (has_pre) {
        float ss = 0.f;
#pragma unroll
        for (int j = 0; j < 4; ++j) ss += (v[j][0] * v[j][0] + v[j][1] * v[j][1]) + (v[j][2] * v[j][2] + v[j][3] * v[j][3]);
        const float rstd = 1.0f / sqrtf(wave_sum(ss) * (1.0f / D) + EPS);
        u32x2* ho = (u32x2*)((bf16_t*)(pp->ws + WS_H) + (size_t)r * D) + lane;
#pragma unroll
        for (int j = 0; j < 4; ++j) { const f32x4 h = (v[j] * rstd) * pa[j] + pb[j]; u32x2 w; w.x = pk2(h[0], h[1]); w.y = pk2(h[2], h[3]); __builtin_nontemporal_store(w, ho + 64 * j); }
    }
}
__device__ __forceinline__ void rows_vectors(CP pp, int mode, int modrow, int li, int k, float wgt, int has_pre, int li2, int k2, f32x4 (&gg)[4], f32x4 (&pa)[4], f32x4 (&pb)[4], int lane) {
    const float* MOD = (const float*)(pp->ws + WS_MOD);
#pragma unroll
    for (int j = 0; j < 4; ++j) { gg[j] = (f32x4){0.f, 0.f, 0.f, 0.f}; pa[j] = gg[j]; pb[j] = gg[j]; }
    if (mode == 1) {
        const f32x4* gate = (const f32x4*)(MOD + (size_t)(li * 9 + modrow) * 9216 + (3 * k + 2) * 1024) + lane;
        const f32x4* gp = (const f32x4*)(pp->in[7] + (size_t)(li * 3 + k) * 1024) + lane;
#pragma unroll
        for (int j = 0; j < 4; ++j) gg[j] = gate[64 * j] * gp[64 * j] * wgt;
    }
    if (has_pre) {
        const f32x4* g = (const f32x4*)(pp->in[6] + (size_t)(li2 * 3 + k2) * 1024) + lane;
        const f32x4* sh = (const f32x4*)(MOD + (size_t)(li2 * 9 + modrow) * 9216 + (3 * k2) * 1024) + lane;
        const f32x4* sc = (const f32x4*)(MOD + (size_t)(li2 * 9 + modrow) * 9216 + (3 * k2 + 1) * 1024) + lane;
#pragma unroll
        for (int j = 0; j < 4; ++j) { pa[j] = g[64 * j] * (sc[64 * j] + 1.0f); pb[j] = sh[64 * j]; }
    }
}
__device__ __forceinline__ void phase_rows(CP pp, int mode, int rows, int li, int k, float wgt, int has_pre, int li2, int k2) {
    const int tid = otid(), lane = tid & 63, wave = tid >> 6;
    const int gw = obid() * NWAVES + wave, NGW = gridDim.x * NWAVES, WPB = NGW / NB;
    f32x4 gg[4], pa[4], pb[4];
    {
        const int b = gw / WPB, wi = gw % WPB;
        rows_vectors(pp, mode, b, li, k, wgt, has_pre, li2, k2, gg, pa, pb, lane);
        for (int i = wi; i < SEQ; i += WPB) rows_one(pp, mode, b * SEQ + i, has_pre, gg, pa, pb, lane);
    }
    if (rows > NLAT) {
        rows_vectors(pp, mode, 8, li, k, wgt, has_pre, li2, k2, gg, pa, pb, lane);
        for (int rc = gw; rc < NCTX; rc += NGW) rows_one(pp, mode, NLAT + rc, has_pre, gg, pa, pb, lane);
    }
}

template <int PASS>
__device__ __forceinline__ void lru_pass(CP pp, LAS unsigned char* lds) {
    LAS float* XCF = (LAS float*)lds;
    LAS unsigned char* XCB = lds + 67584;
    LAS unsigned char* GBT = lds + 67584 + 34816;
    const int tid = otid(), lane = tid & 63, wave = tid >> 6, fr = lane & 15, fq = lane >> 4;
    bf16_t* Zl = (bf16_t*)(pp->ws + WS_G);
    const bf16_t* Wg = (const bf16_t*)(pp->ws + WS_WG);
    f32x2* SUM = (f32x2*)(pp->ws + WS_SUM);
    const float* HIN = (const float*)(pp->ws + WS_HIN);
    const float* conv_w = pp->in[12]; const float* conv_b = pp->in[13];
    const int nitems = PASS == 1 ? NB * NSLOT * 8 : NB * 64 * 8;
    for (int item = obid(); item < nitems; item += gridDim.x) {
        const int head = item & 7, rest = item >> 3;
        int b, slot;
        if (PASS == 1) { b = rest / NSLOT; slot = rest % NSLOT; } else { b = rest >> 6; slot = 2 + (rest & 63); }
        int rowbase, t0, L;
        if (slot < 2) { rowbase = NLAT + b * CTXL; t0 = slot * 128; L = CTXL; } else { rowbase = b * SEQ; t0 = (slot - 2) * 128; L = SEQ; }
        {
            const int ch = 2 * lane, gch = head * 128 + ch;
            const f32x2 w0 = *(const f32x2*)(conv_w + 0 * 1024 + gch), w1 = *(const f32x2*)(conv_w + 1 * 1024 + gch), w2 = *(const f32x2*)(conv_w + 2 * 1024 + gch),
                        w3 = *(const f32x2*)(conv_w + 3 * 1024 + gch), cb = *(const f32x2*)(conv_b + gch);
            const int tb = t0 + wave * 16;
            const unsigned* src = (const unsigned*)(Zl + (size_t)rowbase * 2048 + 1024 + gch);
            unsigned raw[19];
#pragma unroll
            for (int i = 0; i < 19; ++i) { const int t = tb - 2 + i; raw[i] = (t >= 0 && t < L) ? src[(size_t)t * 1024] : 0u; }
#pragma unroll
            for (int it = 0; it < 16; ++it) {
                const float x = w0.x * bf_lo(raw[it]) + w1.x * bf_lo(raw[it + 1]) + w2.x * bf_lo(raw[it + 2]) + w3.x * bf_lo(raw[it + 3]) + cb.x;
                const float y = w0.y * bf_hi(raw[it]) + w1.y * bf_hi(raw[it + 1]) + w2.y * bf_hi(raw[it + 2]) + w3.y * bf_hi(raw[it + 3]) + cb.y;
                const int tt = wave * 16 + it;
                *(LAS f32x2*)(XCF + tt * 132 + ch) = (f32x2){x, y};
                *(LAS unsigned*)(XCB + tt * 272 + ch * 2) = pk2(x, y);
            }
            if (PASS == 2) {
#pragma unroll
                for (int it = 0; it < 4; ++it) { const int id = it * NTHR + tid, row = id >> 4, pc = id & 15;
                    *(LAS u32x4*)(GBT + row * 272 + pc * 16) = *(const u32x4*)(Zl + (size_t)(rowbase + t0 + row) * 2048 + head * 128 + pc * 8); }
            }
        }
        __syncthreads();
        {
            const int chw = wave * 16 + fr, gch = head * 128 + chw;
            float hf[8][4];
#pragma unroll
            for (int dir = 0; dir < 2; ++dir) {
                bf16x8 Bf[2][4];
#pragma unroll
                for (int g2 = 0; g2 < 2; ++g2)
#pragma unroll
                    for (int ks = 0; ks < 4; ++ks) Bf[g2][ks] = *(const bf16x8*)(Wg + (size_t)((head * 4 + dir * 2 + g2) * 128 + chw) * 128 + 32 * ks + 8 * fq);
                const float ba = -1.4426950408889634f * pp->in[15][dir * 1024 + gch], bi = -1.4426950408889634f * pp->in[17][dir * 1024 + gch];
                const float lam = pp->in[18][dir * 1024 + gch];
                const float ex = fast_exp(-fmaxf(lam, -20.f));
                const float sp = ex < 0.03f ? ex * (1.0f + ex * (-0.5f + ex * (0.33333333f + ex * (-0.25f + ex * 0.2f))))
                                            : (lam < -20.f ? -lam : __builtin_amdgcn_logf(1.0f + ex) * 0.6931471805599453f);
                const float c8 = 8.0f * sp * 1.4426950408889634f;
                float hcarry = 0.f, Achunk = 1.f;
                if (PASS == 2) hcarry = HIN[(size_t)((dir * NB + b) * NSLOT + slot) * 1024 + gch];
#pragma unroll
                for (int mi = 0; mi < 8; ++mi) {
                    const int m = dir == 0 ? mi : 7 - mi;
                    f32x4 acc0 = {ba, ba, ba, ba}, acc1 = {bi, bi, bi, bi};
#pragma unroll
                    for (int ks = 0; ks < 4; ++ks) {
                        const bf16x8 Af = *(const LAS bf16x8*)(XCB + (16 * m + fr) * 272 + (32 * ks + 8 * fq) * 2);
                        acc0 = __builtin_amdgcn_mfma_f32_16x16x32_bf16(Af, Bf[0][ks], acc0, 0, 0, 0);
                        acc1 = __builtin_amdgcn_mfma_f32_16x16x32_bf16(Af, Bf[1][ks], acc1, 0, 0, 0);
                    }
                    float a[4], bb[4];
#pragma unroll
                    for (int r = 0; r < 4; ++r) {
                        const int tok = 16 * m + 4 * fq + r;
                        const float xc = XCF[tok * 132 + chw];
                        const float rg = __builtin_amdgcn_rcpf(1.0f + __builtin_amdgcn_exp2f(acc0[r])), ig = __builtin_amdgcn_rcpf(1.0f + __builtin_amdgcn_exp2f(acc1[r]));
                        a[r] = __builtin_amdgcn_exp2f(-rg * c8);
                        bb[r] = __builtin_amdgcn_sqrtf(fmaxf(__builtin_fmaf(-a[r], a[r], 1.0f), 0.f)) * (ig * xc);
                    }
                    float Al, Bl;
                    if (dir == 0) { Al = (a[0] * a[1]) * (a[2] * a[3]); Bl = ((bb[0] * a[1] + bb[1]) * a[2] + bb[2]) * a[3] + bb[3]; }
                    else          { Al = (a[0] * a[1]) * (a[2] * a[3]); Bl = ((bb[3] * a[2] + bb[2]) * a[1] + bb[1]) * a[0] + bb[0]; }
                    {
                        float Ap = dir == 0 ? __shfl_up(Al, 16) : __shfl_down(Al, 16), Bp = dir == 0 ? __shfl_up(Bl, 16) : __shfl_down(Bl, 16);
                        const bool ok1 = dir == 0 ? (fq >= 1) : (fq <= 2);
                        if (ok1) { Bl = Al * Bp + Bl; Al = Al * Ap; }
                        Ap = dir == 0 ? __shfl_up(Al, 32) : __shfl_down(Al, 32); Bp = dir == 0 ? __shfl_up(Bl, 32) : __shfl_down(Bl, 32);
                        const bool ok2 = dir == 0 ? (fq >= 2) : (fq <= 1);
                        if (ok2) { Bl = Al * Bp + Bl; Al = Al * Ap; }
                    }
                    const int srcl = dir == 0 ? 48 + fr : fr;
                    const float At = __shfl(Al, srcl), Bt = __shfl(Bl, srcl);
                    if (PASS == 2) {
                        float Ae = dir == 0 ? __shfl_up(Al, 16) : __shfl_down(Al, 16), Be = dir == 0 ? __shfl_up(Bl, 16) : __shfl_down(Bl, 16);
                        const bool first = dir == 0 ? (fq == 0) : (fq == 3);
                        if (first) { Ae = 1.f; Be = 0.f; }
                        float h = Ae * hcarry + Be;
#pragma unroll
                        for (int rr = 0; rr < 4; ++rr) {
                            const int r = dir == 0 ? rr : 3 - rr;
                            h = a[r] * h + bb[r];
                            if (dir == 0) hf[m][r] = h;
                            else {
                                const int tok = 16 * m + 4 * fq + r;
                                LAS unsigned short* gp = (LAS unsigned short*)(GBT + tok * 272 + chw * 2);
                                const float gb = __builtin_bit_cast(float, ((unsigned)*gp) << 16);
                                *gp = (unsigned short)pk2((hf[m][r] + h) * gb, 0.f);
                            }
                        }
                    }
                    hcarry = At * hcarry + Bt; Achunk *= At;
                    asm volatile("" ::: "memory");
                }
                if (PASS == 1) { if (fq == 0) SUM[(size_t)((dir * NB + b) * NSLOT + slot) * 1024 + gch] = (f32x2){Achunk, hcarry}; }
            }
        }
        __syncthreads();
        if (PASS == 2) {
#pragma unroll
            for (int it = 0; it < 4; ++it) { const int id = it * NTHR + tid, row = id >> 4, pc = id & 15;
                *(u32x4*)(Zl + (size_t)(rowbase + t0 + row) * 2048 + head * 128 + pc * 8) = *(const LAS u32x4*)(GBT + row * 272 + pc * 16); }
            __syncthreads();
        }
    }
}

__device__ __forceinline__ void lru_carry(CP pp) {
    const f32x2* SUM = (const f32x2*)(pp->ws + WS_SUM);
    float* HIN = (float*)(pp->ws + WS_HIN);
    for (int gt = obid() * NTHR + otid(); gt < 2 * NB * 1024; gt += gridDim.x * NTHR) {
        const int dir = gt >> 13, rest = gt & 8191;
        const size_t base = (size_t)(dir * NB + (rest >> 10)) * NSLOT * 1024 + (rest & 1023);
        float h = 0.f;
#pragma unroll 1
        for (int j = 0; j < 3; ++j) {
            f32x2 ab[22];
#pragma unroll
            for (int ii = 0; ii < 22; ++ii) { const int i = 22 * j + ii; const int s = dir == 0 ? i : (i == 0 ? 1 : (i == 1 ? 0 : NSLOT + 1 - i)); ab[ii] = SUM[base + (size_t)s * 1024]; }
#pragma unroll
            for (int ii = 0; ii < 22; ++ii) { const int i = 22 * j + ii; const int s = dir == 0 ? i : (i == 0 ? 1 : (i == 1 ? 0 : NSLOT + 1 - i)); HIN[base + (size_t)s * 1024] = h; h = ab[ii].x * h + ab[ii].y; }
        }
    }
}

__device__ __forceinline__ void sgu_spatial(CP pp, LAS unsigned char* lds) {
    LAS unsigned* VT = (LAS unsigned*)lds;
    LAS unsigned char* WST = lds + 67584;
    LAS float* MU = (LAS float*)(lds + 67584 + 34816);
    LAS float* RS = MU + 128;
    LAS float* M1 = MU + 256;
    LAS float* M2 = MU + 384;
    const int tid = otid(), lane = tid & 63, wave = tid >> 6, fr = lane & 15, fq = lane >> 4;
    bf16_t* Zs = (bf16_t*)(pp->ws + WS_G);
    const f32x2* STAT = (const f32x2*)(pp->ws + WS_Y);
    const bf16_t* WsB = (const bf16_t*)(pp->ws + WS_WSB);
    const float* ln_g = pp->in[22]; const float* ln_b = pp->in[23]; const float* bs = pp->in[25];
    for (int cidx = obid(); cidx < 512; cidx += gridDim.x) {
        const int r0 = cidx * 128;
#pragma unroll
        for (int it = 0; it < 4; ++it) {
            const int id = it * NTHR + tid, pp_ = id >> 4;
            const f32x4 t = *(const f32x4*)((const float*)(STAT + (size_t)r0 * 32) + (size_t)id * 4);
            float sm = t[0] + t[2], sq = t[1] + t[3];
#pragma unroll
            for (int o = 1; o < 16; o <<= 1) { sm += __shfl_xor(sm, o); sq += __shfl_xor(sq, o); }
            if ((id & 15) == 0) { const float mean = sm * (1.0f / DSGU), var = sq * (1.0f / DSGU) - mean * mean; MU[pp_] = mean; RS[pp_] = 1.0f / sqrtf(fmaxf(var, 0.f) + EPS); }
        }
        __syncthreads();
#pragma unroll 1
        for (int g = 0; g < 8; ++g) {
            {
                const int cb = tid & 31;
                u32x4 raw[8];
#pragma unroll
                for (int it = 0; it < 8; ++it) raw[it] = __builtin_nontemporal_load((const u32x4*)(Zs + (size_t)(r0 + it * 16 + (tid >> 5)) * 4096 + 2048 + 256 * g + 8 * cb));
#pragma unroll
                for (int it = 0; it < 8; ++it) *(LAS u32x4*)(VT + (it * 16 + (tid >> 5)) * 132 + cb * 4) = raw[it];
            }
#pragma unroll
            for (int it = 0; it < 4; ++it) {
                const int id = it * NTHR + tid, q = id >> 4, pc = id & 15;
                const u32x4 rw = *(const u32x4*)(WsB + (size_t)(g * 128 + q) * 128 + pc * 8);
                const f32x4 rs0 = *(const LAS f32x4*)(RS + 8 * pc), rs1 = *(const LAS f32x4*)(RS + 8 * pc + 4), mu0 = *(const LAS f32x4*)(MU + 8 * pc), mu1 = *(const LAS f32x4*)(MU + 8 * pc + 4);
                const f32x4 w0 = {bf_lo(rw.x), bf_hi(rw.x), bf_lo(rw.y), bf_hi(rw.y)}, w1 = {bf_lo(rw.z), bf_hi(rw.z), bf_lo(rw.w), bf_hi(rw.w)};
                float m2p = (w0[0] + w0[1]) + (w0[2] + w0[3]) + (w1[0] + w1[1]) + (w1[2] + w1[3]);
                const f32x4 s0 = w0 * rs0, s1 = w1 * rs1;
                u32x4 wp; wp.x = pk2(s0[0], s0[1]); wp.y = pk2(s0[2], s0[3]); wp.z = pk2(s1[0], s1[1]); wp.w = pk2(s1[2], s1[3]);
                *(LAS u32x4*)(WST + q * 272 + pc * 16) = wp;
                float m1p = (bf_lo(wp.x) * mu0[0] + bf_hi(wp.x) * mu0[1]) + (bf_lo(wp.y) * mu0[2] + bf_hi(wp.y) * mu0[3]) + (bf_lo(wp.z) * mu1[0] + bf_hi(wp.z) * mu1[1]) + (bf_lo(wp.w) * mu1[2] + bf_hi(wp.w) * mu1[3]);
#pragma unroll
                for (int o = 1; o < 16; o <<= 1) { m1p += __shfl_xor(m1p, o); m2p += __shfl_xor(m2p, o); }
                if (pc == 0) { M1[q] = m1p; M2[q] = m2p; }
            }
            __syncthreads();
            {
                const int c0 = 32 * wave, cch = 256 * g + c0 + 8 * fq;
                u32x4 uu[8];
#pragma unroll
                for (int m = 0; m < 8; ++m) uu[m] = __builtin_nontemporal_load((const u32x4*)(Zs + (size_t)(r0 + 16 * m + fr) * 4096 + cch));
                float bsv[8];
#pragma unroll
                for (int m = 0; m < 8; ++m) bsv[m] = bs[g * 128 + 16 * m + fr];
                const f32x4 lg0 = *(const f32x4*)(ln_g + cch), lg1 = *(const f32x4*)(ln_g + cch + 4), lb0 = *(const f32x4*)(ln_b + cch), lb1 = *(const f32x4*)(ln_b + cch + 4);
                bf16x8 Vf[2][4];
#pragma unroll
                for (int n = 0; n < 2; ++n) {
                    const int col = c0 + 8 * (fr >> 2) + 4 * n + (fr & 3), word = col >> 1, sh = (col & 1) * 16;
#pragma unroll
                    for (int ks = 0; ks < 4; ++ks) {
                        unsigned e[8];
#pragma unroll
                        for (int i = 0; i < 8; ++i) e[i] = (VT[(32 * ks + 8 * fq + i) * 132 + word] >> sh) & 0xffffu;
                        u32x4 w; w.x = e[0] | (e[1] << 16); w.y = e[2] | (e[3] << 16); w.z = e[4] | (e[5] << 16); w.w = e[6] | (e[7] << 16);
                        Vf[n][ks] = __builtin_bit_cast(bf16x8, w);
                        asm volatile("" ::: "memory");
                    }
                }
#pragma unroll
                for (int m = 0; m < 8; ++m) {
                    f32x4 acc[2] = {{0.f, 0.f, 0.f, 0.f}, {0.f, 0.f, 0.f, 0.f}};
#pragma unroll
                    for (int ks = 0; ks < 4; ++ks) {
                        const bf16x8 Wf = *(const LAS bf16x8*)(WST + (16 * m + fr) * 272 + (32 * ks + 8 * fq) * 2);
                        acc[0] = __builtin_amdgcn_mfma_f32_16x16x32_bf16(Vf[0][ks], Wf, acc[0], 0, 0, 0);
                        acc[1] = __builtin_amdgcn_mfma_f32_16x16x32_bf16(Vf[1][ks], Wf, acc[1], 0, 0, 0);
                    }
                    const int q = 16 * m + fr; const float m1 = M1[q], m2 = M2[q], bsq = bsv[m];
                    const f32x4 s0 = lg0 * (acc[0] - m1) + (lb0 * m2 + bsq), s1 = lg1 * (acc[1] - m1) + (lb1 * m2 + bsq);
                    u32x4* up = (u32x4*)(Zs + (size_t)(r0 + q) * 4096 + cch);
                    const u32x4 u_ = uu[m]; u32x4 w;
                    w.x = pk2(bf_lo(u_.x) * s0[0], bf_hi(u_.x) * s0[1]); w.y = pk2(bf_lo(u_.y) * s0[2], bf_hi(u_.y) * s0[3]);
                    w.z = pk2(bf_lo(u_.z) * s1[0], bf_hi(u_.z) * s1[1]); w.w = pk2(bf_lo(u_.w) * s1[2], bf_hi(u_.w) * s1[3]);
                    *up = w;
                    asm volatile("" ::: "memory");
                }
            }
            __syncthreads();
        }
    }
}

#define FB_LD(p) __hip_atomic_load((p), __ATOMIC_RELAXED, __HIP_MEMORY_SCOPE_AGENT)
#define FB_ST(p, v) __hip_atomic_store((p), (v), __ATOMIC_RELAXED, __HIP_MEMORY_SCOPE_AGENT)
__device__ __forceinline__ void flag_barrier(unsigned* base, unsigned gen) {
    asm volatile("s_waitcnt vmcnt(0)" ::: "memory");
    __syncthreads();
    if (threadIdx.x < 64) {
        const int c = blockIdx.x, G = gridDim.x, lane = threadIdx.x;
        __builtin_amdgcn_fence(__ATOMIC_RELEASE, "agent");
        asm volatile("s_waitcnt vmcnt(0)" ::: "memory");
        if (lane == 0) FB_ST(base + 64 * (1 + c), gen);
        if (c == 0) {
            unsigned sp = 0;
            for (;;) {
                unsigned ok = 1u;
                for (int m = lane; m < G; m += 64) ok &= (unsigned)(FB_LD(base + 64 * (1 + m)) >= gen);
                if (__all((int)ok)) break;
                __builtin_amdgcn_s_sleep(1); if (++sp > (1u << 22)) break;
            }
            if (lane == 0) FB_ST(base, gen);
        }
        { unsigned sp = 0; while (FB_LD(base) < gen) { __builtin_amdgcn_s_sleep(1); if (++sp > (1u << 22)) break; } }
        __builtin_amdgcn_fence(__ATOMIC_ACQUIRE, "agent");
        asm volatile("s_waitcnt vmcnt(0)" ::: "memory");
    }
    __syncthreads();
}

__device__ __forceinline__ void run_phase(CP pp, int ph, LAS unsigned char* lds) {
    unsigned char* ws = pp->ws;
    bf16_t* H = (bf16_t*)(ws + WS_H); bf16_t* G = (bf16_t*)(ws + WS_G); bf16_t* Y = (bf16_t*)(ws + WS_Y);
    int ffn = -1, sub = 0;
    if (ph >= 2 && ph <= 4) { ffn = 0; sub = ph - 2; } else if (ph >= 11 && ph <= 13) { ffn = 1; sub = ph - 11; }
    else if (ph >= 14 && ph <= 16) { ffn = 2; sub = ph - 14; } else if (ph >= 21 && ph <= 23) { ffn = 3; sub = ph - 21; }
    if ((PHM & 1) && ph == 0) { phase_prep(pp, lds); return; }
    if ((PHM & 2) && ph == 1) { phase_rows(pp, 0, MT, 0, 0, 0.f, 1, 0, 0); return; }
    if ((PHM & 4) && ffn >= 0 && sub == 0) {
        const int M = ffn == 0 ? MT : NLAT;
        pg8::Gemm g{H, (const bf16_t*)(ws + WS_WUP) + (size_t)ffn * NUP * 1024, M, NUP, 1024, 1024}; pg8::StaticOrder S; S.init(M, NUP, gridDim.x, obid());
        EpiSwiglu E{G, DFF};
        pg8::gemm_phase<EpiSwiglu, pg8::StaticOrder, true, true>(lds, g, S, E);
        return;
    }
    if ((PHM & 8) && ((ffn >= 0 && sub == 1) || ph == 9 || ph == 19)) {
        int M = NLAT, K = DFF, lda = DFF; const bf16_t* Bt;
        if (ffn >= 0) { M = ffn == 0 ? MT : NLAT; Bt = (const bf16_t*)(ws + WS_WDN) + (size_t)ffn * 1024 * DFF; }
        else if (ph == 9) { K = 1024; lda = 2048; Bt = (const bf16_t*)(ws + WS_LOUT); }
        else { K = 2048; lda = 4096; Bt = (const bf16_t*)(ws + WS_SOUT); }
        pg8::Gemm g{G, Bt, M, 1024, K, lda}; pg8::StaticOrder S; S.init(M, 1024, gridDim.x, obid());
        EpiAct E{Y, 1024, nullptr, 0, 1 << 20, nullptr};
        pg8::gemm_phase<EpiAct, pg8::StaticOrder, true, true>(lds, g, S, E);
        return;
    }
    if ((PHM & 2) && ((ffn >= 0 && sub == 2) || ph == 10 || ph == 20)) {
        int li, k, rows = NLAT, has_pre = 1, li2, k2; float wgt = 0.5f;
        if (ph == 4) { li = 0; k = 0; li2 = 0; k2 = 1; rows = MT; }
        else if (ph == 10) { li = 0; k = 1; li2 = 0; k2 = 2; wgt = 1.0f; }
        else if (ph == 13) { li = 0; k = 2; li2 = 1; k2 = 0; }
        else if (ph == 16) { li = 1; k = 0; li2 = 1; k2 = 1; }
        else if (ph == 20) { li = 1; k = 1; li2 = 1; k2 = 2; wgt = 1.0f; }
        else { li = 1; k = 2; li2 = 1; k2 = 2; has_pre = 0; }
        phase_rows(pp, 1, rows, li, k, wgt, has_pre, li2, k2);
        return;
    }
    if ((PHM & 16) && (ph == 5 || ph == 17)) {
        int M, N; const bf16_t* Bt; EpiAct E;
        if (ph == 5) { M = MT; N = 2048; Bt = (const bf16_t*)(ws + WS_LIN); E = EpiAct{G, 2048, nullptr, 4, 1 << 20, nullptr}; }
        else { M = NLAT; N = 4096; Bt = (const bf16_t*)(ws + WS_SIN); E = EpiAct{G, 4096, pp->in[21], 16, 8, (f32x2*)(ws + WS_Y)}; }
        pg8::Gemm g{H, Bt, M, N, 1024, 1024}; pg8::StaticOrder S; S.init(M, N, gridDim.x, obid());
        pg8::gemm_phase<EpiAct, pg8::StaticOrder, true, true>(lds, g, S, E);
        return;
    }
    if ((PHM & 32) && ph == 6) { lru_pass<1>(pp, lds); return; }
    if ((PHM & 64) && ph == 7) { lru_carry(pp); return; }
    if ((PHM & 128) && ph == 8) { lru_pass<2>(pp, lds); return; }
    if ((PHM & 256) && ph == 18) { sgu_spatial(pp, lds); return; }
}

__device__ __forceinline__ CP get_params() {
    CP k = (CP)__builtin_amdgcn_kernarg_segment_ptr();
    asm volatile("" : "+s"(k));
    return k;
}
__global__ void __launch_bounds__(NTHR, 2) trunk_fwd(Params p) {
    extern __shared__ __attribute__((aligned(16))) unsigned char lds_raw[];
    LAS unsigned char* lds = (LAS unsigned char*)lds_raw;
    const int lo = p.ph_lo, hi = p.ph_hi;
#if ONE_LAUNCH
    if (blockIdx.x == 0) { unsigned* cw = (unsigned*)(p.ws + WS_CTL); for (int i = threadIdx.x; i < 64 * ((int)gridDim.x + 1); i += NTHR) cw[i] = 0u; }
#endif
    unsigned bgen = 0u;
    for (int ph = lo; ph < hi; ++ph) {
        run_phase(get_params(), ph, lds);
#if ONE_LAUNCH
        if (ph + 1 < hi) {
            if (ph == lo) { __syncthreads(); cg::this_grid().sync(); }
            else { flag_barrier((unsigned*)(get_params()->ws + WS_CTL), ++bgen);
#ifdef PROBE_DOUBLE
                   flag_barrier((unsigned*)(get_params()->ws + WS_CTL), ++bgen);
#endif
            }
        }
#endif
    }
}

extern "C" void kernel_launch(void* const* d_in, const int* in_sizes, int n_in, void* d_out, int out_size, void* d_ws, size_t ws_size, hipStream_t stream) {
    static int grid = 0;
    if (grid == 0) {
        if (n_in != 27 || ws_size < WS_END) { fprintf(stderr, "kernel_launch: unexpected n_in %d / ws_size %zu\n", n_in, ws_size); grid = -1; return; }
        if (hipFuncSetAttribute((const void*)trunk_fwd, hipFuncAttributeMaxDynamicSharedMemorySize, LDS_BYTES) != hipSuccess) { fprintf(stderr, "hipFuncSetAttribute failed\n"); grid = -1; return; }
        int dev = 0, cus = 0, per_cu = 0;
        hipGetDevice(&dev); hipDeviceGetAttribute(&cus, hipDeviceAttributeMultiprocessorCount, dev);
        hipOccupancyMaxActiveBlocksPerMultiprocessor(&per_cu, (const void*)trunk_fwd, NTHR, LDS_BYTES);
        (void)hipGetLastError();
        if (per_cu < 1) fprintf(stderr, "kernel_launch: occupancy query says %d blocks per CU\n", per_cu);
        grid = cus > 0 ? cus : 256;
    }
    if (grid < 0) return;
    Params p{};
    for (int i = 0; i < 27; ++i) p.in[i] = (const float*)d_in[i];
    p.out = (float*)d_out; p.ws = (unsigned char*)d_ws;
#if ONE_LAUNCH
    p.ph_lo = 0; p.ph_hi = NPHASE;
    void* args[] = {&p};
    hipError_t e = hipLaunchCooperativeKernel((const void*)trunk_fwd, dim3(grid), dim3(NTHR), args, LDS_BYTES, stream);
    if (e != hipSuccess) fprintf(stderr, "cooperative launch failed: %s (grid %d)\n", hipGetErrorString(e), grid);
#else
    for (int ph = 0; ph < NPHASE; ++ph) {
        p.ph_lo = ph; p.ph_hi = ph + 1;
        hipLaunchKernelGGL(trunk_fwd, dim3(grid), dim3(NTHR), LDS_BYTES, stream, p);
    }
#endif
}
```
